# Optimizing an MI355X kernel written in HIP

```python
import math
import jax, jax.numpy as jnp
from jax import lax
import numpy as np

D_MODEL = 1024
BATCH = 2
SEQ = 8192
DEPTH = 2

D_MIX = D_MODEL
D_CONV = D_MIX // 4
D_ATTN = D_MIX // 2
D_SGU = D_MIX // 4
N_ATTN_HEADS = 4
ATTN_V_DIM = D_ATTN // N_ATTN_HEADS
ATTN_QK_DIM = ATTN_V_DIM // 2
Q_BLOCK = 128
CONV_WIDTH = 31
N_SGU_GROUPS = 4
SGU_GROUP_DIM = D_SGU // N_SGU_GROUPS
CHUNK = 128
D_IN = 2 * D_CONV + 3 * D_ATTN + 2 * D_SGU + D_MIX
EPS = 1e-6
NEG_INF = -1e30

kernel_name = "hybrid_conv_diffattn_sgu_block"


def _rms_norm(x, g):
    xf = x.astype(jnp.float32)
    y = xf * lax.rsqrt(jnp.mean(xf * xf, axis=-1, keepdims=True) + EPS)
    return (y * g.astype(jnp.float32)).astype(x.dtype)


def _layer_norm(x, g, b):
    xf = x.astype(jnp.float32)
    mu = jnp.mean(xf, axis=-1, keepdims=True)
    xc = xf - mu
    y = xc * lax.rsqrt(jnp.mean(xc * xc, axis=-1, keepdims=True) + EPS)
    return (y * g.astype(jnp.float32) + b.astype(jnp.float32)).astype(x.dtype)


def _conv_branch(h, conv_w, conv_b, ln_g, ln_b):
    a, gt = jnp.split(h, 2, axis=-1)
    z = a * jax.nn.sigmoid(gt)
    z = lax.conv_general_dilated(
        z, conv_w[:, None, :].astype(z.dtype),
        window_strides=(1,), padding=[(CONV_WIDTH - 1, 0)],
        dimension_numbers=("NWC", "WIO", "NWC"),
        feature_group_count=D_CONV) + conv_b
    z = _layer_norm(z, ln_g, ln_b)
    return jax.nn.silu(z)


def _diff_attention(q, k, v, lam, lam_init, subln_g):
    B, S, _ = q.shape
    q = q.reshape(B, S, N_ATTN_HEADS, 2, ATTN_QK_DIM)
    k = k.reshape(B, S, N_ATTN_HEADS, 2, ATTN_QK_DIM)
    v = v.reshape(B, S, N_ATTN_HEADS, ATTN_V_DIM)
    scale = 1.0 / math.sqrt(ATTN_QK_DIM)
    slopes = jnp.exp2(-8.0 * (jnp.arange(N_ATTN_HEADS, dtype=jnp.float32) + 1.0) / N_ATTN_HEADS)
    kpos = jnp.arange(S)
    n_blocks = S // Q_BLOCK

    def block(i):
        qb = lax.dynamic_slice_in_dim(q, i * Q_BLOCK, Q_BLOCK, axis=1)
        s = jnp.einsum('bqhcd,bkhcd->bhcqk', qb, k).astype(jnp.float32) * scale
        qpos = i * Q_BLOCK + jnp.arange(Q_BLOCK)
        rel = qpos[:, None] - kpos[None, :]
        alibi = -slopes[:, None, None] * rel.astype(jnp.float32)[None]
        s = jnp.where((rel >= 0)[None, None, None], s + alibi[None, :, None], NEG_INF)
        p = jax.nn.softmax(s, axis=-1)
        pd = p[:, :, 0] - lam * p[:, :, 1]
        return jnp.einsum('bhqk,bkhv->bqhv', pd.astype(v.dtype), v)

    o = lax.map(block, jnp.arange(n_blocks))
    o = jnp.transpose(o, (1, 0, 2, 3, 4)).reshape(B, S, N_ATTN_HEADS, ATTN_V_DIM)
    o = _rms_norm(o, subln_g) * (1.0 - lam_init)
    return o.reshape(B, S, D_ATTN)


def _sgu_branch(h, ln_g, ln_b, w_s, b_s):
    B, S, _ = h.shape
    u, vv = jnp.split(h, 2, axis=-1)
    vv = _layer_norm(vv, ln_g, ln_b)
    vv = vv.reshape(B, S // CHUNK, CHUNK, N_SGU_GROUPS, SGU_GROUP_DIM)
    w = w_s * jnp.tril(jnp.ones((CHUNK, CHUNK), w_s.dtype))[None]
    mixed = jnp.einsum('gts,bcsgd->bctgd', w, vv) + b_s.T[None, None, :, :, None]
    return u * mixed.reshape(B, S, D_SGU)


def setup_inputs(seed: int = 0) -> dict:
    key = jax.random.key(seed)
    ks = jax.random.split(key, 20)
    f32 = jnp.float32
    n = lambda k, shape: jax.random.normal(k, shape, f32)
    return {
        "x": n(ks[0], (BATCH, SEQ, D_MODEL)),
        "norm_g": 1.0 + 0.02 * n(ks[1], (DEPTH, D_MODEL)),
        "w_in": n(ks[2], (DEPTH, D_MODEL, D_IN)) * D_MODEL ** -0.5,
        "conv_w": n(ks[3], (DEPTH, CONV_WIDTH, D_CONV)) * CONV_WIDTH ** -0.5,
        "conv_b": 0.02 * n(ks[4], (DEPTH, D_CONV)),
        "conv_ln_g": 1.0 + 0.02 * n(ks[5], (DEPTH, D_CONV)),
        "conv_ln_b": 0.02 * n(ks[6], (DEPTH, D_CONV)),
        "lam_q1": 0.1 * n(ks[7], (DEPTH, ATTN_QK_DIM)),
        "lam_k1": 0.1 * n(ks[8], (DEPTH, ATTN_QK_DIM)),
        "lam_q2": 0.1 * n(ks[9], (DEPTH, ATTN_QK_DIM)),
        "lam_k2": 0.1 * n(ks[10], (DEPTH, ATTN_QK_DIM)),
        "subln_g": 1.0 + 0.02 * n(ks[11], (DEPTH, ATTN_V_DIM)),
        "sgu_ln_g": 1.0 + 0.02 * n(ks[12], (DEPTH, D_SGU)),
        "sgu_ln_b": 0.02 * n(ks[13], (DEPTH, D_SGU)),
        "w_s": n(ks[14], (DEPTH, N_SGU_GROUPS, CHUNK, CHUNK)) * CHUNK ** -0.5,
        "b_s": 1.0 + 0.02 * n(ks[15], (DEPTH, N_SGU_GROUPS, CHUNK)),
        "w_out": n(ks[16], (DEPTH, D_MIX, D_MODEL)) * D_MIX ** -0.5,
        "norm_f": 1.0 + 0.02 * n(ks[17], (D_MODEL,)),
    }


def reference(x, norm_g, w_in, conv_w, conv_b, conv_ln_g, conv_ln_b,
              lam_q1, lam_k1, lam_q2, lam_k2, subln_g,
              sgu_ln_g, sgu_ln_b, w_s, b_s, w_out, norm_f):
    splits = np.cumsum([2 * D_CONV, D_ATTN, D_ATTN, D_ATTN, 2 * D_SGU]).tolist()
    for l in range(DEPTH):
        lam_init = 0.8 - 0.6 * math.exp(-0.3 * l)
        lam = (jnp.exp(jnp.sum(lam_q1[l].astype(jnp.float32) * lam_k1[l].astype(jnp.float32)))
               - jnp.exp(jnp.sum(lam_q2[l].astype(jnp.float32) * lam_k2[l].astype(jnp.float32)))
               + lam_init)
        h = _rms_norm(x, norm_g[l])
        proj = jnp.einsum('bsd,de->bse', h, w_in[l])
        p_conv, p_q, p_k, p_v, p_sgu, gate = jnp.split(proj, splits, axis=-1)
        y_a = _conv_branch(p_conv, conv_w[l], conv_b[l], conv_ln_g[l], conv_ln_b[l])
        y_b = _diff_attention(p_q, p_k, p_v, lam, lam_init, subln_g[l])
        y_c = _sgu_branch(p_sgu, sgu_ln_g[l], sgu_ln_b[l], w_s[l], b_s[l])
        y = jnp.concatenate([y_a, y_b, y_c], axis=-1) * jax.nn.silu(gate)
        x = x + jnp.einsum('bse,ed->bsd', y, w_out[l])
    return _rms_norm(x, norm_f)
```

```cpp
#include <hip/hip_runtime.h>
#include <cstdint>
#include <cstdio>

namespace {
constexpr int D_MODEL = 1024, BATCH = 2, SEQ = 8192, DEPTH = 2;
constexpr int D_CONV = 256, D_ATTN = 512, D_SGU = 256, D_MIX = 1024;
constexpr int NH = 4, VD = 128, QK = 64, CONV_W = 31, NG = 4, GD = 64, CHUNK = 128;
constexpr int D_IN = 3584;
constexpr int OFF_CONV = 0, OFF_Q = 512, OFF_K = 1024, OFF_V = 1536, OFF_SGU = 2048, OFF_GATE = 2560;
constexpr float EPS = 1e-6f;

__device__ __forceinline__ float wave_sum(float v) {
#pragma unroll
    for (int o = 1; o < 64; o <<= 1) v += __shfl_xor(v, o);
    return v;
}
__device__ __forceinline__ float sigmoidf_(float x) { return 1.f / (1.f + __expf(-x)); }
__device__ __forceinline__ float siluf_(float x) { return x / (1.f + __expf(-x)); }

__global__ void __launch_bounds__(256) k_rmsnorm(const float* x, const float* __restrict__ g, float* y, int rows) {
    const int wave = (blockIdx.x * 256 + threadIdx.x) >> 6, lane = threadIdx.x & 63;
    if (wave >= rows) return;
    const float* xr = x + (size_t)wave * D_MODEL;
    float v[16]; float s = 0.f;
#pragma unroll
    for (int j = 0; j < 16; ++j) { v[j] = xr[lane + 64 * j]; s += v[j] * v[j]; }
    s = wave_sum(s);
    const float r = rsqrtf(s * (1.f / D_MODEL) + EPS);
#pragma unroll
    for (int j = 0; j < 16; ++j) y[(size_t)wave * D_MODEL + lane + 64 * j] = v[j] * r * g[lane + 64 * j];
}

__global__ void __launch_bounds__(256) k_sgemm(const float* __restrict__ A, const float* __restrict__ B, float* C, const float* R, int M, int N, int K) {
    __shared__ float As[16][68];
    __shared__ float Bs[16][68];
    const int tx = threadIdx.x & 15, ty = threadIdx.x >> 4;
    const int m0 = blockIdx.y * 64, n0 = blockIdx.x * 64;
    float acc[4][4];
#pragma unroll
    for (int i = 0; i < 4; ++i)
#pragma unroll
        for (int j = 0; j < 4; ++j) acc[i][j] = 0.f;
    for (int k0 = 0; k0 < K; k0 += 16) {
        {
            const int r = threadIdx.x >> 2, c = (threadIdx.x & 3) * 4;
            const float4 a = *(const float4*)(A + (size_t)(m0 + r) * K + k0 + c);
            As[c + 0][r] = a.x; As[c + 1][r] = a.y; As[c + 2][r] = a.z; As[c + 3][r] = a.w;
            const int br = threadIdx.x >> 4, bc = (threadIdx.x & 15) * 4;
            const float4 b = *(const float4*)(B + (size_t)(k0 + br) * N + n0 + bc);
            Bs[br][bc + 0] = b.x; Bs[br][bc + 1] = b.y; Bs[br][bc + 2] = b.z; Bs[br][bc + 3] = b.w;
        }
        __syncthreads();
#pragma unroll
        for (int kk = 0; kk < 16; ++kk) {
            float a[4], b[4];
#pragma unroll
            for (int i = 0; i < 4; ++i) a[i] = As[kk][ty * 4 + i];
#pragma unroll
            for (int j = 0; j < 4; ++j) b[j] = Bs[kk][tx * 4 + j];
#pragma unroll
            for (int i = 0; i < 4; ++i)
#pragma unroll
                for (int j = 0; j < 4; ++j) acc[i][j] = fmaf(a[i], b[j], acc[i][j]);
        }
        __syncthreads();
    }
#pragma unroll
    for (int i = 0; i < 4; ++i) {
        const size_t off = (size_t)(m0 + ty * 4 + i) * N + n0 + tx * 4;
        float4 o = make_float4(acc[i][0], acc[i][1], acc[i][2], acc[i][3]);
        if (R) { const float4 r = *(const float4*)(R + off); o.x += r.x; o.y += r.y; o.z += r.z; o.w += r.w; }
        *(float4*)(C + off) = o;
    }
}

__global__ void __launch_bounds__(256) k_conv(const float* __restrict__ proj, const float* __restrict__ cw, const float* __restrict__ cb,
                                              const float* __restrict__ lg, const float* __restrict__ lb, float* __restrict__ Y) {
    __shared__ float red[8];
    const int t = blockIdx.x, c = threadIdx.x;
    float acc = cb[c];
    for (int j = 0; j < CONV_W; ++j) {
        const int ts = t - (CONV_W - 1) + j;
        if (ts >= 0) {
            const float a = proj[(size_t)ts * D_IN + OFF_CONV + c], gt = proj[(size_t)ts * D_IN + OFF_CONV + D_CONV + c];
            acc = fmaf(cw[j * D_CONV + c], a * sigmoidf_(gt), acc);
        }
    }
    float s = wave_sum(acc);
    if ((c & 63) == 0) red[c >> 6] = s;
    __syncthreads();
    const float mean = (red[0] + red[1] + red[2] + red[3]) * (1.f / D_CONV);
    const float d = acc - mean;
    float q = wave_sum(d * d);
    if ((c & 63) == 0) red[4 + (c >> 6)] = q;
    __syncthreads();
    const float var = (red[4] + red[5] + red[6] + red[7]) * (1.f / D_CONV);
    const float yv = d * rsqrtf(var + EPS) * lg[c] + lb[c];
    const float gate = proj[(size_t)t * D_IN + OFF_GATE + c];
    Y[(size_t)t * D_MIX + c] = siluf_(yv) * siluf_(gate);
}

__global__ void __launch_bounds__(64) k_attn(const float* __restrict__ proj, float* __restrict__ OM) {
    const int q = blockIdx.x * 64 + threadIdx.x;
    const int h = blockIdx.y >> 3, map = (blockIdx.y >> 2) & 1, vq = blockIdx.y & 3;
    const float slope = exp2f(-8.f * (float)(h + 1) / (float)NH);
    float qv[QK];
    const float* qp = proj + (size_t)q * D_IN + OFF_Q + h * 128 + map * 64;
#pragma unroll
    for (int d = 0; d < QK; ++d) qv[d] = qp[d] * 0.125f;
    float o[32];
#pragma unroll
    for (int d = 0; d < 32; ++d) o[d] = 0.f;
    float m = -1e30f, l = 0.f;
    const int kmax = blockIdx.x * 64 + 63;
    for (int k = 0; k <= kmax; ++k) {
        const float* kp = proj + (size_t)k * D_IN + OFF_K + h * 128 + map * 64;
        const float* vp = proj + (size_t)k * D_IN + OFF_V + h * 128 + vq * 32;
        float s = 0.f;
#pragma unroll
        for (int d = 0; d < QK; ++d) s = fmaf(qv[d], kp[d], s);
        s -= slope * (float)(q - k);
        if (k <= q) {
            const float mn = fmaxf(m, s);
            const float a = __expf(m - mn), p = __expf(s - mn);
            l = l * a + p;
#pragma unroll
            for (int d = 0; d < 32; ++d) o[d] = fmaf(o[d], a, p * vp[d]);
            m = mn;
        }
    }
    const float il = 1.f / l;
    float* op = OM + ((size_t)map * SEQ + q) * D_ATTN + h * 128 + vq * 32;
#pragma unroll
    for (int d = 0; d < 32; ++d) op[d] = o[d] * il;
}

__global__ void __launch_bounds__(512) k_attn_combine(const float* __restrict__ OM, const float* __restrict__ proj, const float* __restrict__ subg,
                                                      const float* __restrict__ lq1, const float* __restrict__ lk1, const float* __restrict__ lq2, const float* __restrict__ lk2,
                                                      float lam_init, float* __restrict__ Y) {
    __shared__ float red[8];
    const int t = blockIdx.x, c = threadIdx.x;
    float s1 = lq1[c & 63] * lk1[c & 63], s2 = lq2[c & 63] * lk2[c & 63];
    s1 = wave_sum(s1); s2 = wave_sum(s2);
    const float lam = __expf(s1) - __expf(s2) + lam_init;
    const float o = OM[(size_t)t * D_ATTN + c] - lam * OM[((size_t)SEQ + t) * D_ATTN + c];
    const float ss = wave_sum(o * o);
    if ((c & 63) == 0) red[c >> 6] = ss;
    __syncthreads();
    const int h = c >> 7;
    const float ms = (red[2 * h] + red[2 * h + 1]) * (1.f / VD);
    const float yv = o * rsqrtf(ms + EPS) * subg[c & 127] * (1.f - lam_init);
    const float gate = proj[(size_t)t * D_IN + OFF_GATE + D_CONV + c];
    Y[(size_t)t * D_MIX + D_CONV + c] = yv * siluf_(gate);
}

__global__ void __launch_bounds__(256) k_sgu_ln(const float* __restrict__ proj, const float* __restrict__ lg, const float* __restrict__ lb, float* __restrict__ VVLN) {
    __shared__ float red[8];
    const int t = blockIdx.x, c = threadIdx.x;
    const float v = proj[(size_t)t * D_IN + OFF_SGU + D_SGU + c];
    float s = wave_sum(v);
    if ((c & 63) == 0) red[c >> 6] = s;
    __syncthreads();
    const float mean = (red[0] + red[1] + red[2] + red[3]) * (1.f / D_SGU);
    const float d = v - mean;
    float q = wave_sum(d * d);
    if ((c & 63) == 0) red[4 + (c >> 6)] = q;
    __syncthreads();
    const float var = (red[4] + red[5] + red[6] + red[7]) * (1.f / D_SGU);
    VVLN[(size_t)t * D_SGU + c] = d * rsqrtf(var + EPS) * lg[c] + lb[c];
}

__global__ void __launch_bounds__(256) k_sgu_mix(const float* __restrict__ proj, const float* __restrict__ VVLN, const float* __restrict__ ws_, const float* __restrict__ bs, float* __restrict__ Y) {
    const int t = blockIdx.x, c = threadIdx.x, g = c >> 6;
    const int tl = t & (CHUNK - 1), t0 = t - tl;
    float acc = bs[g * CHUNK + tl];
    for (int s = 0; s <= tl; ++s) acc = fmaf(ws_[((size_t)g * CHUNK + tl) * CHUNK + s], VVLN[(size_t)(t0 + s) * D_SGU + c], acc);
    const float u = proj[(size_t)t * D_IN + OFF_SGU + c];
    const float gate = proj[(size_t)t * D_IN + OFF_GATE + D_CONV + D_ATTN + c];
    Y[(size_t)t * D_MIX + D_CONV + D_ATTN + c] = u * acc * siluf_(gate);
}
}

extern "C" void kernel_launch(void* const* d_in, const int* in_sizes, int n_in, void* d_out, int out_size, void* d_ws, size_t ws_size, hipStream_t stream) {
    const float* x = (const float*)d_in[0];
    const float* norm_g = (const float*)d_in[1];
    const float* w_in = (const float*)d_in[2];
    const float* conv_w = (const float*)d_in[3];
    const float* conv_b = (const float*)d_in[4];
    const float* conv_ln_g = (const float*)d_in[5];
    const float* conv_ln_b = (const float*)d_in[6];
    const float* lam_q1 = (const float*)d_in[7];
    const float* lam_k1 = (const float*)d_in[8];
    const float* lam_q2 = (const float*)d_in[9];
    const float* lam_k2 = (const float*)d_in[10];
    const float* subln_g = (const float*)d_in[11];
    const float* sgu_ln_g = (const float*)d_in[12];
    const float* sgu_ln_b = (const float*)d_in[13];
    const float* w_s = (const float*)d_in[14];
    const float* b_s = (const float*)d_in[15];
    const float* w_out = (const float*)d_in[16];
    const float* norm_f = (const float*)d_in[17];
    float* out = (float*)d_out;
    char* ws = (char*)d_ws;
    const size_t MiB = 1u << 20;
    float* XN = (float*)(ws);
    float* PROJ = (float*)(ws + 32 * MiB);
    float* OM = (float*)(ws + 144 * MiB);
    float* VVLN = (float*)(ws + 176 * MiB);
    float* Y = (float*)(ws + 184 * MiB);
    hipMemcpyAsync(out, x, (size_t)BATCH * SEQ * D_MODEL * 4, hipMemcpyDeviceToDevice, stream);
    for (int l = 0; l < DEPTH; ++l) {
        const float lam_init = 0.8f - 0.6f * expf(-0.3f * (float)l);
        for (int b = 0; b < BATCH; ++b) {
            float* xb = out + (size_t)b * SEQ * D_MODEL;
            k_rmsnorm<<<SEQ / 4, 256, 0, stream>>>(xb, norm_g + l * D_MODEL, XN, SEQ);
            k_sgemm<<<dim3(D_IN / 64, SEQ / 64), 256, 0, stream>>>(XN, w_in + (size_t)l * D_MODEL * D_IN, PROJ, nullptr, SEQ, D_IN, D_MODEL);
            k_conv<<<SEQ, 256, 0, stream>>>(PROJ, conv_w + l * CONV_W * D_CONV, conv_b + l * D_CONV, conv_ln_g + l * D_CONV, conv_ln_b + l * D_CONV, Y);
            k_attn<<<dim3(SEQ / 64, NH * 2 * 4), 64, 0, stream>>>(PROJ, OM);
            k_attn_combine<<<SEQ, 512, 0, stream>>>(OM, PROJ, subln_g + l * VD, lam_q1 + l * QK, lam_k1 + l * QK, lam_q2 + l * QK, lam_k2 + l * QK, lam_init, Y);
            k_sgu_ln<<<SEQ, 256, 0, stream>>>(PROJ, sgu_ln_g + l * D_SGU, sgu_ln_b + l * D_SGU, VVLN);
            k_sgu_mix<<<SEQ, 256, 0, stream>>>(PROJ, VVLN, w_s + (size_t)l * NG * CHUNK * CHUNK, b_s + l * NG * CHUNK, Y);
            k_sgemm<<<dim3(D_MODEL / 64, SEQ / 64), 256, 0, stream>>>(Y, w_out + (size_t)l * D_MIX * D_MODEL, xb, xb, SEQ, D_MODEL, D_MIX);
        }
    }
    k_rmsnorm<<<BATCH * SEQ / 4, 256, 0, stream>>>(out, norm_f, out, BATCH * SEQ);
}
```

```cpp
#define FAST_MASK 0xFF
#define A_OVH 4
#include <hip/hip_runtime.h>
#include <cstdio>
#include <cstdint>
#include <cmath>

constexpr int D_MODEL = 1024, BATCH = 2, SEQ = 8192, DEPTH = 2, M_TOK = BATCH * SEQ;
constexpr int D_CONV = 256, D_ATTN = 512, D_SGU = 256, D_MIX = 1024;
constexpr int NH = 4, VD = 128, QKD = 64, CONV_W = 31, NG = 4, GD = 64, CHUNK = 128;
constexpr int D_IN = 3584;
constexpr int PPITCH = 2304;
constexpr int PC_Z = 0, PC_Q = 256, PC_U = 768, PC_VV = 1024, PC_G = 1280;
__host__ __device__ __forceinline__ size_t kt_off(int row, int c) { const int b = row >> 13, t = (row & 8191) >> 6, r = row & 63, h = c >> 7, cc = c & 127; return ((((size_t)(b * 4 + h) * 128 + t) * 2 + (cc >> 6)) * 8 + ((cc & 63) >> 3)) * 512 + r * 8 + (cc & 7); }
__host__ __device__ __forceinline__ size_t vt_off(int row, int c) { const int b = row >> 13, t = (row & 8191) >> 6, r = row & 63, h = c >> 7, cc = c & 127; return (((size_t)(b * 4 + h) * 128 + t) * 4 + (cc >> 5)) * 2048 + r * 32 + (cc & 31); }
constexpr float EPS = 1e-6f;
constexpr float LOG2E = 1.4426950408889634f;
constexpr float C2 = 0.125f * LOG2E;

namespace pg8 {
#define PG8_LAS __attribute__((address_space(3)))
typedef unsigned short bf16_t;
typedef short bf16x8 __attribute__((ext_vector_type(8)));
typedef float f32x4 __attribute__((ext_vector_type(4)));
typedef unsigned u32x4 __attribute__((ext_vector_type(4)));
constexpr int BM = 256, BK = 64, HALF = 128, HTB = HALF * BK * 2  , STAGE_BYTES = 8 * HTB, NXCD = 8, WGM = 8;

__host__ __device__ __forceinline__ int lds_byte(int r, int c) { const int st = (r >> 4) * 2 + (c >> 5), rr = r & 15, cc = c & 31, ob = rr * 64 + cc * 2; return st * 1024 + (ob ^ (((ob >> 9) & 1) << 5)); }
__host__ __device__ __forceinline__ void stage_rc(int b, int& R, int& C) { const int st = b / 1024, sb = b % 1024, swz = sb ^ (((sb >> 9) & 1) << 5); R = (st >> 1) * 16 + swz / 64; C = (st & 1) * 32 + (swz % 64) / 2; }
__host__ __device__ __forceinline__ int perm32(int rho) { const int n = rho >> 4, i = rho & 15; return 8 * (i >> 2) + 4 * n + (i & 3); }
struct Unit { int pm, pn; };
struct Gemm { const bf16_t* A; const bf16_t* Bt; int M, N, K; };

struct StaticOrder {
    int nM, nN, nwg, G, c;
    __host__ __device__ void init(int M, int N, int G_, int c_) { nM = M / BM; nN = N / BM; nwg = nM * nN; G = G_; c = c_; }
    __host__ __device__ bool next(int i, Unit& u) const {
        const long L = (long)i * G + c; if (L >= nwg) return false;
        int wgid = (int)L; { const int q = nwg / NXCD, r = nwg % NXCD, xcd = wgid % NXCD, off = wgid / NXCD; wgid = (xcd < r ? xcd * (q + 1) : r * (q + 1) + (xcd - r) * q) + off; }
        const int nig = WGM * nN, gid = wgid / nig, fm = gid * WGM, gsz = (nM - fm) < WGM ? (nM - fm) : WGM;
        u.pm = fm + ((wgid % nig) % gsz); u.pn = (wgid % nig) / gsz; return true;
    }
    __device__ __forceinline__ void a_ready(const Unit&) const {}
    __device__ __forceinline__ void done(const Unit&) const {}
};


__device__ __forceinline__ unsigned cvt_pk_bf16(float lo, float hi) { unsigned r; asm volatile("v_cvt_pk_bf16_f32 %0, %1, %2" : "=v"(r) : "v"(lo), "v"(hi)); return r; }
__device__ __forceinline__ float xsum16(float v) { auto r = __builtin_amdgcn_permlane16_swap(__float_as_uint(v), __float_as_uint(v), false, false); return __uint_as_float(r[0]) + __uint_as_float(r[1]); }
__device__ __forceinline__ float xsum32(float v) { auto r = __builtin_amdgcn_permlane32_swap(__float_as_uint(v), __float_as_uint(v), false, false); return __uint_as_float(r[0]) + __uint_as_float(r[1]); }
template <int CTRL> __device__ __forceinline__ float dppf(float x) { return __builtin_bit_cast(float, __builtin_amdgcn_update_dpp(0, __builtin_bit_cast(int, x), CTRL, 0xf, 0xf, true)); }
__device__ __forceinline__ float rowmax16(float x) { x = fmaxf(x, dppf<0x121>(x)); x = fmaxf(x, dppf<0x122>(x)); x = fmaxf(x, dppf<0x124>(x)); x = fmaxf(x, dppf<0x128>(x)); return x; }
__device__ __forceinline__ float fast_sigmoid(float x) { return __builtin_amdgcn_rcpf(1.f + __builtin_amdgcn_exp2f(-1.4426950408889634f * x)); }
struct EpiIn {
    static constexpr bool PERM = true, AFTER_DRAIN = false;
    bf16_t* P; const float* ssqp; unsigned* nrm; bf16_t* KT; bf16_t* VT;
    __device__ __forceinline__ void operator()(const f32x4 (&acc)[2][2][4][2], const Unit& u, int wr, int wc, int fr, int fq) const {
        const int row0 = u.pm * BM + wr * 64 + fr;
        float rsv[2][4];
        { float p4[2][4][4];
#pragma unroll
          for (int ai = 0; ai < 2; ++ai)
#pragma unroll
              for (int m = 0; m < 4; ++m) { const int row_ = row0 + ai * HALF + m * 16;
#pragma unroll
                  for (int k = 0; k < 4; ++k) p4[ai][m][k] = ssqp[k * 16384 + row_]; }
#pragma unroll
          for (int ai = 0; ai < 2; ++ai)
#pragma unroll
              for (int m = 0; m < 4; ++m) rsv[ai][m] = __builtin_amdgcn_rsqf(((p4[ai][m][0] + p4[ai][m][1]) + (p4[ai][m][2] + p4[ai][m][3])) * (1.0f / 1024.0f) + 1e-6f); }
#define RS_OF(ai, m) rsv[ai][m]
        const int pn = u.pn;
        if (pn < 2) {
            const int col0 = pn * 128 + wc * 32 + 8 * fq;
#pragma unroll
            for (int ai = 0; ai < 2; ++ai)
#pragma unroll
                for (int m = 0; m < 4; ++m) { const float r = RS_OF(ai, m);
                    const f32x4 a0 = acc[ai][0][m][0] * r, a1 = acc[ai][0][m][1] * r, g0 = acc[ai][1][m][0] * r, g1 = acc[ai][1][m][1] * r;
                    u32x4 w; w.x = cvt_pk_bf16(a0[0] * fast_sigmoid(g0[0]), a0[1] * fast_sigmoid(g0[1])); w.y = cvt_pk_bf16(a0[2] * fast_sigmoid(g0[2]), a0[3] * fast_sigmoid(g0[3]));
                    w.z = cvt_pk_bf16(a1[0] * fast_sigmoid(g1[0]), a1[1] * fast_sigmoid(g1[1])); w.w = cvt_pk_bf16(a1[2] * fast_sigmoid(g1[2]), a1[3] * fast_sigmoid(g1[3]));
                    *(u32x4*)(P + (size_t)(row0 + ai * HALF + m * 16) * 2304 + col0) = w; asm volatile("" ::: "memory"); }
        } else {
            const int cbase = (pn == 2) ? 768 : (pn == 3) ? 1024 : (pn == 4) ? 1280 : (pn == 5) ? (1280 + 768) : (pn < 8) ? (256 + (pn - 6) * 256) : (1280 + 256 + (pn - 12) * 256);
            const int col0 = cbase + wc * 32 + 8 * fq; const bool kv = (pn >= 8 && pn < 12);
            const float sc = (pn == 6 || pn == 7) ? 0.18033688011112042f : 1.0f;
            const bool act = (pn == 4 || pn == 5 || pn >= 12); const bool qk = (pn >= 6 && pn < 10);
            float nmx0 = 0.f, nmx1 = 0.f;
#pragma unroll
            for (int ai = 0; ai < 2; ++ai)
#pragma unroll
                for (int m = 0; m < 4; ++m) { const float r = RS_OF(ai, m) * sc; const int row_ = row0 + ai * HALF + m * 16; bf16_t* rowp = P + (size_t)row_ * 2304 + col0;
#pragma unroll
                    for (int bj = 0; bj < 2; ++bj) { f32x4 v0 = acc[ai][bj][m][0] * r, v1 = acc[ai][bj][m][1] * r;
                        if (qk) { float s2 = ((v0[0] * v0[0] + v0[1] * v0[1]) + (v0[2] * v0[2] + v0[3] * v0[3])) + ((v1[0] * v1[0] + v1[1] * v1[1]) + (v1[2] * v1[2] + v1[3] * v1[3]));
                            s2 = xsum16(s2); s2 = xsum32(s2); if (bj == 0) nmx0 = fmaxf(nmx0, s2); else nmx1 = fmaxf(nmx1, s2); }
                        if (act) {
#pragma unroll
                            for (int e = 0; e < 4; ++e) { v0[e] = v0[e] * fast_sigmoid(v0[e]); v1[e] = v1[e] * fast_sigmoid(v1[e]); } }
                        u32x4 w; w.x = cvt_pk_bf16(v0[0], v0[1]); w.y = cvt_pk_bf16(v0[2], v0[3]); w.z = cvt_pk_bf16(v1[0], v1[1]); w.w = cvt_pk_bf16(v1[2], v1[3]);
                        if (!kv) *(u32x4*)(rowp + bj * HALF) = w;
                        else { const int c_ = (pn & 1) * 256 + bj * HALF + wc * 32 + 8 * fq; if (pn < 10) *(u32x4*)(KT + kt_off(row_, c_)) = w; else *(u32x4*)(VT + vt_off(row_, c_)) = w; } }
                    asm volatile("" ::: "memory"); }
            if (qk) {
                nmx0 = rowmax16(nmx0); nmx1 = rowmax16(nmx1);
                if (fr == 0 && fq == 0) { unsigned* d = nrm + ((u.pm >> 5) * 2 + ((pn - 6) >> 1)) * 16 + (2 * (pn & 1)) * 4 + (wc >> 1) * 2 + (wc & 1);
                    atomicMax(d, __float_as_uint(nmx0)); atomicMax(d + 4, __float_as_uint(nmx1)); }
            }
        }
    }
};
struct EpiOut {
    static constexpr bool PERM = false, AFTER_DRAIN = true;
    const float* base; float* out; bf16_t* xb; float* ssqp;
    __device__ __forceinline__ void fused(f32x4 (&acc)[2][2][4][2], const Unit& u, int wr, int wc, int fr, int fq, PG8_LAS unsigned char* lds, int wid, int lane) const {
        typedef unsigned u32x2v __attribute__((ext_vector_type(2)));
        PG8_LAS float* Pq = (PG8_LAS float*)lds;
        const int col0 = u.pn * BM + wc * 32 + 4 * fq;
#pragma unroll
        for (int ai = 0; ai < 2; ++ai)
#pragma unroll
            for (int m = 0; m < 4; ++m) { const int r = ai * HALF + wr * 64 + m * 16 + fr; const size_t off = (size_t)(u.pm * BM + r) * 1024 + col0; float s = 0.f;
#pragma unroll
                for (int bj = 0; bj < 2; ++bj)
#pragma unroll
                    for (int n = 0; n < 2; ++n) { const f32x4 bs = *(const f32x4*)(base + off + bj * HALF + n * 16); const f32x4 o = bs + acc[ai][bj][m][n];
                        if (out) *(f32x4*)(out + off + bj * HALF + n * 16) = o; s += (o[0] * o[0] + o[1] * o[1]) + (o[2] * o[2] + o[3] * o[3]);
                        u32x2v w; w.x = cvt_pk_bf16(o[0], o[1]); w.y = cvt_pk_bf16(o[2], o[3]); *(u32x2v*)(xb + off + bj * HALF + n * 16) = w; }
                s = xsum16(s); s = xsum32(s);
                if (fq == 0) Pq[r * 4 + wc] = s;
                if (m == 3) asm volatile("" ::: "memory"); }
        asm volatile("s_waitcnt lgkmcnt(0)" ::: "memory"); __builtin_amdgcn_s_barrier(); asm volatile("" ::: "memory");
        const int t = wid * 64 + lane;
        if (t < 256) ssqp[(size_t)u.pn * 16384 + u.pm * BM + t] = (Pq[t * 4 + 0] + Pq[t * 4 + 1]) + (Pq[t * 4 + 2] + Pq[t * 4 + 3]);
        asm volatile("s_waitcnt lgkmcnt(0)" ::: "memory"); __builtin_amdgcn_s_barrier(); asm volatile("" ::: "memory");
    }
};

struct EpiOutFinal {
    static constexpr bool PERM = false, AFTER_DRAIN = true;
    const bf16_t* xb; float* out; const float* gain; float* xbuf; unsigned* cnt;
    __device__ __forceinline__ void fused(f32x4 (&acc)[2][2][4][2], const Unit& u, int wr, int wc, int fr, int fq, PG8_LAS unsigned char* lds, int wid, int lane) const {
        typedef unsigned u32x2v __attribute__((ext_vector_type(2)));
        PG8_LAS float* Pq = (PG8_LAS float*)lds;
        PG8_LAS float* S = (PG8_LAS float*)(lds + 4096);
        const int col0 = u.pn * BM + wc * 32 + 4 * fq;
#pragma unroll
        for (int ai = 0; ai < 2; ++ai)
#pragma unroll
            for (int m = 0; m < 4; ++m) { const int r = ai * HALF + wr * 64 + m * 16 + fr; const size_t off = (size_t)(u.pm * BM + r) * 1024 + col0; float s = 0.f;
#pragma unroll
                for (int bj = 0; bj < 2; ++bj)
#pragma unroll
                    for (int n = 0; n < 2; ++n) { const u32x2v b = *(const u32x2v*)(xb + off + bj * HALF + n * 16);
                        f32x4 o = acc[ai][bj][m][n]; o[0] += __uint_as_float(b.x << 16); o[1] += __uint_as_float(b.x & 0xffff0000u); o[2] += __uint_as_float(b.y << 16); o[3] += __uint_as_float(b.y & 0xffff0000u);
                        acc[ai][bj][m][n] = o; s += (o[0] * o[0] + o[1] * o[1]) + (o[2] * o[2] + o[3] * o[3]); }
                s = xsum16(s); s = xsum32(s);
                if (fq == 0) Pq[r * 4 + wc] = s;
                }
        asm volatile("s_waitcnt lgkmcnt(0)" ::: "memory"); __builtin_amdgcn_s_barrier(); asm volatile("" ::: "memory");
        const int t = wid * 64 + lane;
        if (t < 256) __hip_atomic_store(xbuf + (size_t)(u.pm * BM + t) * 4 + u.pn, (Pq[t * 4 + 0] + Pq[t * 4 + 1]) + (Pq[t * 4 + 2] + Pq[t * 4 + 3]), __ATOMIC_RELAXED, __HIP_MEMORY_SCOPE_AGENT);
        asm volatile("s_waitcnt vmcnt(0)" ::: "memory");
        if (wid < 4 && lane == 0) __hip_atomic_fetch_add(cnt + 16 * u.pm, 1u, __ATOMIC_RELAXED, __HIP_MEMORY_SCOPE_AGENT);
        if (wid == 0) { unsigned spins = 0;
            while ((unsigned)__builtin_amdgcn_readfirstlane(__hip_atomic_load(cnt + 16 * u.pm, __ATOMIC_RELAXED, __HIP_MEMORY_SCOPE_AGENT)) < 16u) { __builtin_amdgcn_s_sleep(2); if (++spins > (1u << 22)) break; }
            __builtin_amdgcn_fence(__ATOMIC_ACQUIRE, "agent"); }
        asm volatile("s_waitcnt vmcnt(0) lgkmcnt(0)" ::: "memory"); __builtin_amdgcn_s_barrier(); asm volatile("" ::: "memory");
        if (t < 256) { const float* sl = xbuf + (size_t)(u.pm * BM + t) * 4; float q = 0.f;
#pragma unroll
            for (int k = 0; k < 4; ++k) q += __hip_atomic_load(sl + k, __ATOMIC_RELAXED, __HIP_MEMORY_SCOPE_AGENT);
            S[t] = __builtin_amdgcn_rsqf(q * (1.0f / 1024.0f) + 1e-6f); }
        asm volatile("s_waitcnt lgkmcnt(0)" ::: "memory"); __builtin_amdgcn_s_barrier(); asm volatile("" ::: "memory");
#pragma unroll
        for (int bj = 0; bj < 2; ++bj)
#pragma unroll
            for (int n = 0; n < 2; ++n) { const f32x4 gv = *(const f32x4*)(gain + col0 + bj * HALF + n * 16);
#pragma unroll
                for (int ai = 0; ai < 2; ++ai)
#pragma unroll
                    for (int m = 0; m < 4; ++m) { const int r = ai * HALF + wr * 64 + m * 16 + fr; const float rs = S[r];
                        *(f32x4*)(out + (size_t)(u.pm * BM + r) * 1024 + col0 + bj * HALF + n * 16) = acc[ai][bj][m][n] * rs * gv; } }
        asm volatile("s_waitcnt lgkmcnt(0)" ::: "memory"); __builtin_amdgcn_s_barrier(); asm volatile("" ::: "memory");
    }
};


template <class Epi, class Sched, bool ALIGN_EPI = false, bool SP2 = false>
__device__ __forceinline__ void gemm_phase(PG8_LAS unsigned char* lds, const Gemm g, const Sched& S, const Epi& E) {
    int tid_ = threadIdx.x; asm volatile("" : "+v"(tid_));
    const int tid = tid_, wid = __builtin_amdgcn_readfirstlane(tid >> 6), lane = tid & 63, wr = wid >> 2, wc = wid & 3, fr = lane & 15, fq = lane >> 4;
    const int K = g.K, nt = K / BK;
    unsigned voffA[2], voffB[2];
#pragma unroll
    for (int i = 0; i < 2; ++i) { int R, C; stage_rc(tid * 16 + i * 8192, R, C); const int Rb = Epi::PERM ? ((R & ~31) + perm32(R & 31)) : R;
        voffA[i] = (unsigned)(R * K + C) * 2u; voffB[i] = (unsigned)(Rb * K + C) * 2u; }
    const size_t kstep = (size_t)(BK * 2);
    const size_t hstep = (size_t)HALF * K * 2;
    const size_t tstep = 2 * hstep;
    const unsigned ldsw = (unsigned)wid * 1024u;
    const int aoff = lds_byte(wr * 64 + fr, fq * 8), boff = lds_byte(wc * 32 + fr, fq * 8);
#define PG8_SA(b, h) (((b) * 2 + (h)) * HTB)
#define PG8_SB(b, h) ((4 + (b) * 2 + (h)) * HTB)
#define PG8_STAGE(bufoff, gbase, voff) do { _Pragma("unroll") for (int _i = 0; _i < 2; ++_i) \
        __builtin_amdgcn_global_load_lds((const unsigned*)((const char*)(gbase) + (voff)[_i]), (PG8_LAS unsigned*)(lds + (bufoff) + ldsw + _i * 8192), 16, 0, 0); } while (0)
#define PG8_LDA(dst, b, h) do { _Pragma("unroll") for (int m = 0; m < 4; ++m) _Pragma("unroll") for (int k = 0; k < 2; ++k) dst[m][k] = *(const PG8_LAS bf16x8*)(lds + PG8_SA(b, h) + aoff + m * 2048 + k * 1024); } while (0)
#define PG8_LDB(dst, b, h) do { _Pragma("unroll") for (int n = 0; n < 2; ++n) _Pragma("unroll") for (int k = 0; k < 2; ++k) dst[n][k] = *(const PG8_LAS bf16x8*)(lds + PG8_SB(b, h) + boff + n * 2048 + k * 1024); } while (0)
#define PG8_MMA(ai, bj, At, Bt) do { __builtin_amdgcn_s_setprio(1); _Pragma("unroll") for (int m = 0; m < 4; ++m) _Pragma("unroll") for (int n = 0; n < 2; ++n) _Pragma("unroll") for (int k = 0; k < 2; ++k) \
        acc[ai][bj][m][n] = __builtin_amdgcn_mfma_f32_16x16x32_bf16(Bt[n][k], At[m][k], acc[ai][bj][m][n], 0, 0, 0); __builtin_amdgcn_s_setprio(0); } while (0)
#define PG8_WAIT_V(n) asm volatile("s_waitcnt vmcnt(" #n ")" ::: "memory")
#define PG8_WAIT_L(n) asm volatile("s_waitcnt lgkmcnt(" #n ")" ::: "memory")
#define PG8_BAR __builtin_amdgcn_s_barrier()
#define PG8_SCHED __builtin_amdgcn_sched_barrier(0)
    Unit cur, nxt; int ui = 0;
    if (!S.next(0, cur)) return;
    f32x4 acc[2][2][4][2];
#pragma unroll
    for (int a = 0; a < 2; ++a)
#pragma unroll
        for (int b = 0; b < 2; ++b)
#pragma unroll
            for (int m = 0; m < 4; ++m)
#pragma unroll
                for (int n = 0; n < 2; ++n) acc[a][b][m][n] = (f32x4){0.f, 0.f, 0.f, 0.f};
    bf16x8 At[4][2], B0[2][2], B1[2][2];
    const char* cA = (const char*)g.A + (size_t)cur.pm * tstep; const char* cB = (const char*)g.Bt + (size_t)cur.pn * tstep;
    S.a_ready(cur);
    if constexpr (SP2) {
        PG8_STAGE(PG8_SB(0, 0), cB, voffB); PG8_STAGE(PG8_SB(0, 1), cB + hstep, voffB); PG8_STAGE(PG8_SA(0, 0), cA, voffA); PG8_STAGE(PG8_SA(0, 1), cA + hstep, voffA);
        if (wr == 1) PG8_BAR;
        PG8_WAIT_V(2); PG8_BAR;
        PG8_STAGE(PG8_SB(1, 0), cB + kstep, voffB); PG8_STAGE(PG8_SA(1, 0), cA + kstep, voffA); PG8_STAGE(PG8_SB(1, 1), cB + hstep + kstep, voffB);
        PG8_WAIT_V(6); PG8_BAR;
    } else {
        PG8_STAGE(PG8_SB(0, 0), cB, voffB); PG8_STAGE(PG8_SA(0, 0), cA, voffA); PG8_STAGE(PG8_SB(0, 1), cB + hstep, voffB); PG8_STAGE(PG8_SA(0, 1), cA + hstep, voffA);
        if (wr == 1) PG8_BAR;
        PG8_WAIT_V(4); PG8_BAR;
        PG8_STAGE(PG8_SB(1, 0), cB + kstep, voffB); PG8_STAGE(PG8_SA(1, 0), cA + kstep, voffA); PG8_STAGE(PG8_SB(1, 1), cB + hstep + kstep, voffB);
        PG8_WAIT_V(6); PG8_BAR;
    }
    for (;;) {
        const bool has_next = S.next(ui + 1, nxt);
        const char* nA = has_next ? (const char*)g.A + (size_t)nxt.pm * tstep : cA; const char* nB = has_next ? (const char*)g.Bt + (size_t)nxt.pn * tstep : cB;
        for (int t = 0; t < nt; t += 2) {
            const bool last = (t == nt - 2);
            const char* a1 = cA + (size_t)(t + 1) * kstep;
            const char* a2 = last ? nA : cA + (size_t)(t + 2) * kstep; const char* b2 = last ? nB : cB + (size_t)(t + 2) * kstep;
            const char* a3 = a2 + kstep; const char* b3 = b2 + kstep;
            if (last && has_next) S.a_ready(nxt);
            if constexpr (SP2) {
            PG8_LDB(B0, 0, 0); PG8_LDB(B1, 0, 1); PG8_SCHED; PG8_LDA(At, 0, 0); PG8_STAGE(PG8_SA(1, 1), a1 + hstep, voffA);
            PG8_WAIT_V(8); PG8_WAIT_L(0); PG8_BAR; PG8_MMA(0, 0, At, B0); PG8_MMA(0, 1, At, B1); PG8_BAR; PG8_SCHED;
            PG8_LDA(At, 0, 1); PG8_STAGE(PG8_SB(0, 0), b2, voffB); PG8_STAGE(PG8_SB(0, 1), b2 + hstep, voffB); PG8_STAGE(PG8_SA(0, 0), a2, voffA);
            PG8_WAIT_V(8); PG8_WAIT_L(0); PG8_BAR; PG8_MMA(1, 0, At, B0); PG8_MMA(1, 1, At, B1); PG8_BAR; PG8_SCHED;
            PG8_LDB(B0, 1, 0); PG8_LDB(B1, 1, 1); PG8_SCHED; PG8_LDA(At, 1, 0); PG8_STAGE(PG8_SA(0, 1), a2 + hstep, voffA);
            PG8_WAIT_V(8); PG8_WAIT_L(0); PG8_BAR; PG8_MMA(0, 0, At, B0); PG8_MMA(0, 1, At, B1); PG8_BAR; PG8_SCHED;
            PG8_LDA(At, 1, 1); PG8_STAGE(PG8_SB(1, 0), b3, voffB); PG8_STAGE(PG8_SB(1, 1), b3 + hstep, voffB); PG8_STAGE(PG8_SA(1, 0), a3, voffA);
            PG8_WAIT_V(8); PG8_WAIT_L(0); PG8_BAR; PG8_MMA(1, 0, At, B0); PG8_MMA(1, 1, At, B1); PG8_BAR; PG8_SCHED;
            } else {
            PG8_LDB(B0, 0, 0); PG8_SCHED; PG8_LDA(At, 0, 0); PG8_STAGE(PG8_SA(1, 1), a1 + hstep, voffA);
            PG8_WAIT_L(8); PG8_BAR; PG8_WAIT_L(0); PG8_MMA(0, 0, At, B0); PG8_BAR; PG8_SCHED;
            PG8_LDB(B1, 0, 1); PG8_STAGE(PG8_SB(0, 0), b2, voffB);
            PG8_BAR; PG8_WAIT_L(0); PG8_MMA(0, 1, At, B1); PG8_BAR;
            PG8_LDA(At, 0, 1); PG8_STAGE(PG8_SA(0, 0), a2, voffA);
            PG8_BAR; PG8_WAIT_L(0); PG8_MMA(1, 0, At, B0); PG8_BAR; PG8_SCHED;
            PG8_STAGE(PG8_SB(0, 1), b2 + hstep, voffB);
            PG8_WAIT_V(6); PG8_BAR; PG8_MMA(1, 1, At, B1); PG8_BAR;
            PG8_LDB(B0, 1, 0); PG8_SCHED; PG8_LDA(At, 1, 0); PG8_STAGE(PG8_SA(0, 1), a2 + hstep, voffA);
            PG8_WAIT_L(8); PG8_BAR; PG8_WAIT_L(0); PG8_MMA(0, 0, At, B0); PG8_BAR; PG8_SCHED;
            PG8_LDB(B1, 1, 1); PG8_STAGE(PG8_SB(1, 0), b3, voffB);
            PG8_BAR; PG8_WAIT_L(0); PG8_MMA(0, 1, At, B1); PG8_BAR;
            PG8_LDA(At, 1, 1); PG8_STAGE(PG8_SA(1, 0), a3, voffA);
            PG8_BAR; PG8_WAIT_L(0); PG8_MMA(1, 0, At, B0); PG8_BAR; PG8_SCHED;
            PG8_STAGE(PG8_SB(1, 1), b3 + hstep, voffB);
            PG8_WAIT_V(6); PG8_BAR; PG8_MMA(1, 1, At, B1); PG8_BAR;
            }
        }
        if constexpr (ALIGN_EPI) { if (wr == 0) PG8_BAR; }
        if constexpr (!Epi::AFTER_DRAIN) { E(acc, cur, wr, wc, fr, fq); S.done(cur); }
        if (!has_next) break;
#pragma unroll
        for (int a = 0; a < 2; ++a)
#pragma unroll
            for (int b = 0; b < 2; ++b)
#pragma unroll
                for (int m = 0; m < 4; ++m)
#pragma unroll
                    for (int n = 0; n < 2; ++n) acc[a][b][m][n] = (f32x4){0.f, 0.f, 0.f, 0.f};
        cur = nxt; cA = nA; cB = nB; ++ui;
        if constexpr (ALIGN_EPI) { if (wr == 1) PG8_BAR; }
    }
    PG8_WAIT_V(0);
    if constexpr (!ALIGN_EPI) { if (wr == 0) PG8_BAR; }
    PG8_BAR;
    if constexpr (Epi::AFTER_DRAIN) { E.fused(acc, cur, wr, wc, fr, fq, lds, wid, lane); S.done(cur); }
#undef PG8_SA
#undef PG8_SB
#undef PG8_STAGE
#undef PG8_LDA
#undef PG8_LDB
#undef PG8_MMA
#undef PG8_WAIT_V
#undef PG8_WAIT_L
#undef PG8_BAR
#undef PG8_SCHED
}
}

#define GAS __attribute__((address_space(1)))
#define LAS __attribute__((address_space(3)))
typedef unsigned short bf16;
typedef unsigned v4u __attribute__((ext_vector_type(4)));
typedef float f32x4 __attribute__((ext_vector_type(4)));
typedef short bf16x8 __attribute__((ext_vector_type(8)));
typedef GAS unsigned gu32;
typedef GAS unsigned long long gu64;
#define RLX_AGENT __ATOMIC_RELAXED, __HIP_MEMORY_SCOPE_AGENT
#define LDS_WAIT() asm volatile("s_waitcnt lgkmcnt(0)" ::: "memory")
#define VM_WAIT() asm volatile("s_waitcnt vmcnt(0)" ::: "memory")
__device__ __forceinline__ unsigned long long rt() { return __builtin_amdgcn_s_memrealtime(); }
__device__ __forceinline__ unsigned f2bf(float f) { unsigned u = __builtin_bit_cast(unsigned, f); return (u + 0x7fffu + ((u >> 16) & 1u)) >> 16; }
__device__ __forceinline__ unsigned pk2(float lo, float hi) { return f2bf(lo) | (f2bf(hi) << 16); }

#define XB_TMO      128
#define XB_XCNT(j)  (256  + 64 * (j))
#define XB_XSUB(j)  (1280 + 64 * (j))
#define XB_XGEN(j)  (2304 + 64 * (j))
#define XB_TOP      3328
#define XB_TOPGEN   3392
#define XCD_BAR_WORDS 3456
#define XB_SPIN_CAP (1u << 18)

__device__ __forceinline__ unsigned xb_ld(unsigned* p)              { return __hip_atomic_load(p, __ATOMIC_RELAXED, __HIP_MEMORY_SCOPE_AGENT); }
__device__ __forceinline__ unsigned xb_add(unsigned* p, unsigned v) { return __hip_atomic_fetch_add(p, v, __ATOMIC_RELAXED, __HIP_MEMORY_SCOPE_AGENT); }
__device__ __forceinline__ unsigned xb_xcc_id() { return (unsigned)__builtin_amdgcn_s_getreg((3 << 11) | 20) & 0xFu; }
#define XB_SPIN(cond, bar) do { unsigned _sp = 0; while (cond) { __builtin_amdgcn_s_sleep(1); \
    if ((++_sp & 255u) == 0u) { if (xb_ld(&(bar)[XB_TMO])) break; if (_sp > XB_SPIN_CAP) { atomicAdd(&(bar)[XB_TMO], 1u); break; } } } } while (0)

struct XcdBarrier {
    unsigned* bar; unsigned x;
    volatile LAS unsigned* st;
};

__device__ __forceinline__ XcdBarrier xcd_barrier_post(unsigned* bar, volatile LAS unsigned* st) {
    XcdBarrier b; b.bar = bar; b.x = xb_xcc_id(); b.st = st;
    if (threadIdx.x == 0) (void)xb_add(&bar[XB_XCNT(b.x)], 1u);
    return b;
}
__device__ __forceinline__ void xcd_barrier_complete(unsigned* bar, unsigned x, unsigned& nloc, unsigned& nx) {
    const unsigned G = gridDim.x * gridDim.y * gridDim.z;
    unsigned sum, cnt, mine, sp = 0u;
    for (;;) {
        sum = 0u; cnt = 0u; mine = 0u;
#pragma unroll
        for (unsigned j = 0; j < 16; ++j) { const unsigned c = xb_ld(&bar[XB_XCNT(j)]); sum += c; cnt += (c > 0u) ? 1u : 0u; mine = (j == x) ? c : mine; }
        if (sum == G) break;
        __builtin_amdgcn_s_sleep(1);
        if ((++sp & 255u) == 0u) { if (xb_ld(&bar[XB_TMO])) break; if (sp > XB_SPIN_CAP) { atomicAdd(&bar[XB_TMO], 1u); break; } }
    }
    nloc = mine > 0u ? mine : 1u; nx = cnt > 0u ? cnt : 1u;
}

__device__ __forceinline__ void xcd_barrier(const XcdBarrier& b) {
    asm volatile("s_waitcnt vmcnt(0)" ::: "memory");
    __syncthreads();
    if (threadIdx.x == 0) {
        unsigned* bar = b.bar;
        __builtin_amdgcn_s_waitcnt(0);
        unsigned nloc = b.st[0], nx = b.st[1];
        if (nloc == 0u) { xcd_barrier_complete(bar, b.x, nloc, nx); b.st[0] = nloc; b.st[1] = nx; }
        const unsigned old = xb_add(&bar[XB_XSUB(b.x)], 1u);
        const unsigned gen = old / nloc;
        if (old + 1u == (gen + 1u) * nloc) {
            __builtin_amdgcn_fence(__ATOMIC_RELEASE, "agent");
            asm volatile("s_waitcnt vmcnt(0)" ::: "memory");
            const unsigned og = xb_add(&bar[XB_TOP], 1u);
            const unsigned tg = og / nx;
            if (og + 1u == (tg + 1u) * nx) xb_add(&bar[XB_TOPGEN], 1u);
            else XB_SPIN(xb_ld(&bar[XB_TOPGEN]) == tg, bar);
            __builtin_amdgcn_fence(__ATOMIC_ACQUIRE, "agent");
            xb_add(&bar[XB_XGEN(b.x)], 1u);
            asm volatile("s_waitcnt vmcnt(0)" ::: "memory");
        } else {
            XB_SPIN(xb_ld(&bar[XB_XGEN(b.x)]) == gen, bar);
            __builtin_amdgcn_fence(__ATOMIC_ACQUIRE, "agent");
            asm volatile("s_waitcnt vmcnt(0)" ::: "memory");
        }
    }
    __syncthreads();
}

namespace mix {
typedef short bf16x8 __attribute__((ext_vector_type(8)));
typedef short s16x4 __attribute__((ext_vector_type(4)));
typedef short v4i16_t __attribute__((ext_vector_type(4)));
typedef float f32x16 __attribute__((ext_vector_type(16)));
typedef float f32x4 __attribute__((ext_vector_type(4)));
typedef unsigned u32x4 __attribute__((ext_vector_type(4)));
typedef unsigned u32x2 __attribute__((ext_vector_type(2)));
typedef __attribute__((address_space(3))) const unsigned char* lds_cptr;
typedef __attribute__((address_space(3))) unsigned char* lds_ptr;
#define MIX_WAIT_BAR(N) asm volatile("s_waitcnt vmcnt(" #N ") lgkmcnt(0)\n\ts_barrier" ::: "memory")
#define MIX_LBAR() asm volatile("s_waitcnt lgkmcnt(0)\n\ts_barrier" ::: "memory")
template <int CTRL> __device__ __forceinline__ float dpp_mov(float x) { return __builtin_bit_cast(float, __builtin_amdgcn_update_dpp(0, __builtin_bit_cast(int, x), CTRL, 0xf, 0xf, true)); }
__device__ __forceinline__ float wave_sum(float x) {
    x += dpp_mov<0x121>(x); x += dpp_mov<0x122>(x); x += dpp_mov<0x124>(x); x += dpp_mov<0x128>(x);
    { auto r = __builtin_amdgcn_permlane16_swap(__float_as_uint(x), __float_as_uint(x), false, false); x = __uint_as_float(r[0]) + __uint_as_float(r[1]); }
    { auto r = __builtin_amdgcn_permlane32_swap(__float_as_uint(x), __float_as_uint(x), false, false); x = __uint_as_float(r[0]) + __uint_as_float(r[1]); }
    return x;
}
__device__ __forceinline__ int crow(int r, int hi) { return (r & 3) + 8 * (r >> 2) + 4 * hi; }
__device__ __forceinline__ void glds16(const void* gsrc, unsigned lds_dst) { unsigned keep;
    asm volatile("s_mov_b32 %0, m0\n\ts_mov_b32 m0, %2\n\ts_nop 0\n\tglobal_load_lds_dwordx4 %1, off\n\ts_mov_b32 m0, %0" : "=&s"(keep) : "v"(gsrc), "s"(lds_dst) : "memory"); }
__device__ __forceinline__ unsigned cvtpk(float lo, float hi) { unsigned r; asm("v_cvt_pk_bf16_f32 %0, %1, %2" : "=v"(r) : "v"(lo), "v"(hi)); return r; }
__device__ __forceinline__ s16x4 vtr(lds_cptr p) { return __builtin_bit_cast(s16x4, __builtin_amdgcn_ds_read_tr16_b64_v4i16((__attribute__((address_space(3))) v4i16_t*)p)); }
__device__ __forceinline__ float xhalf_sum(float v) { auto rr = __builtin_amdgcn_permlane32_swap(__float_as_uint(v), __float_as_uint(v), false, false); return __uint_as_float(rr[0]) + __uint_as_float(rr[1]); }
__device__ __forceinline__ float xhalf_max(float v) { auto rr = __builtin_amdgcn_permlane32_swap(__float_as_uint(v), __float_as_uint(v), false, false); return fmaxf(__uint_as_float(rr[0]), __uint_as_float(rr[1])); }

constexpr int A_SLOT = 16384, A_NK = 4, A_NV = 4, A_LDS_K = 0, A_LDS_V = A_NK * A_SLOT, A_LDS_X = 0, A_LDS_CI = (A_NK + A_NV) * A_SLOT, A_LDS_Q = A_LDS_CI + 4096  ;
constexpr int PITCH = PPITCH;
constexpr float THR = 32.0f;
#ifndef SKEW
#define SKEW 1
#endif
#define SBAR() __builtin_amdgcn_sched_barrier(0)
#define PIN(x) asm volatile("" : "+v"(x))
#define MFMA32(a, b, c) __builtin_amdgcn_mfma_f32_32x32x16_bf16(a, b, c, 0, 0, 0)
#define MX3(a, b, c) __builtin_fmaxf(__builtin_fmaxf((a), (b)), (c))
#define EX2(v) ((VAR & 2) ? (v) * 0.5f : __builtin_amdgcn_exp2f(v))
__device__ __forceinline__ bf16x8 kld(lds_cptr p) { return *(const __attribute__((address_space(3))) bf16x8*)p; }
template <int VAR> __device__ __forceinline__ void attn_unit(int b, int h, int qb, int t_lo, int t_end, int pw_lo, int pw_hi, int myw, unsigned epoch, float* slabs, unsigned* flags, const bf16* __restrict__ P, const bf16* __restrict__ KT, const bf16* __restrict__ VT, bf16* __restrict__ Y, float lam, lds_ptr lds, int dry) {
    int tid_ = threadIdx.x; asm volatile("" : "+v"(tid_));
    const int tid = tid_, lane = tid & 63, r32 = lane & 31, hi = lane >> 5; const int wid = __builtin_amdgcn_readfirstlane(tid >> 6), qw = wid & 3, map = wid >> 2;
    const long rowbase = (long)b * SEQ; const int q0 = qb * 128, NT = 2 * (qb + 1), n = t_end - t_lo; const bool band = (t_end == NT);
    const float sl2 = exp2f(-2.0f * (float)(h + 1)) * LOG2E;
    const unsigned lds0 = (unsigned)(uintptr_t)lds;
    const bf16* ksrc = KT + ((size_t)(b * 4 + h) * 128 + t_lo) * 8192 + wid * 512 + lane * 8;
    const bf16* vsrc = VT + ((size_t)(b * 4 + h) * 128 + t_lo) * 8192 + wid * 512 + lane * 8;
    const unsigned kdst = lds0 + A_LDS_K + wid * 1024, vdst = lds0 + A_LDS_V + wid * 1024;
#define DMA_K(i, so) do { if (VAR & 1) break; const bf16* ks_ = ksrc + (long)(i) * 8192; glds16(ks_, (unsigned)__builtin_amdgcn_readfirstlane(kdst + (so))); glds16(ks_ + 4096, (unsigned)__builtin_amdgcn_readfirstlane(kdst + (so) + 8192)); } while (0)
#define DMA_V(i, so) do { if (VAR & 1) break; const bf16* vs_ = vsrc + (long)(i) * 8192; glds16(vs_, (unsigned)__builtin_amdgcn_readfirstlane(vdst + (so))); glds16(vs_ + 4096, (unsigned)__builtin_amdgcn_readfirstlane(vdst + (so) + 8192)); } while (0)
    bf16x8 qr[4];
    { const bf16* qp = P + (rowbase + q0 + qw * 32 + r32) * PITCH + PC_Q + h * 128 + map * 64 + hi * 8;
#pragma unroll
      for (int d0 = 0; d0 < 4; ++d0) qr[d0] = *reinterpret_cast<const bf16x8*>(qp + d0 * 16); }
    DMA_K(0, 0); DMA_V(0, 0); DMA_K(1, A_SLOT);
    if (n > 2) DMA_K(2, 2 * A_SLOT);
    { __attribute__((address_space(3))) f32x4* ci = (__attribute__((address_space(3))) f32x4*)(lds + A_LDS_CI);
#pragma unroll
      for (int k = 0; k < 4; ++k) ci[k * 64 + lane] = (f32x4){sl2 * (float)crow(4 * k, hi), sl2 * (float)crow(4 * k + 1, hi), sl2 * (float)crow(4 * k + 2, hi), sl2 * (float)crow(4 * k + 3, hi)}; }
    const lds_cptr cip = (lds_cptr)lds + A_LDS_CI + lane * 16;
#define CILD(X, k) do { if (VAR & 64) break; const f32x4 t_ = *(const __attribute__((address_space(3))) f32x4*)(cip + (k) * 1024); X[4 * (k)] = t_[0]; X[4 * (k) + 1] = t_[1]; X[4 * (k) + 2] = t_[2]; X[4 * (k) + 3] = t_[3]; } while (0)
    f32x16 ot[4];
#pragma unroll
    for (int d = 0; d < 4; ++d) ot[d] = f32x16{};
    float mhat = 0.f, l_reg = 0.f, fsc = 1.f; bool resc = false;
    const int qrel = qw * 32 + r32;
    const lds_cptr kp0 = (lds_cptr)lds + A_LDS_K + map * 8192 + hi * 1024 + r32 * 16;
    const lds_cptr vp0 = (lds_cptr)lds + A_LDS_V + ((lane >> 4) & 1) * 32 + (lane & 3) * 8 + (4 * hi + ((lane & 15) >> 2)) * 64;
#define KSL(t) ((((t) + 4) & 3) * A_SLOT)
#define KB0(i) (sl2 * (float)(64 * (t_lo + (i)) - q0))
#define CMASK(C0, C1, i) do { const int jb_ = (i) - (n - 2); if (band && jb_ >= 0) { const int kb_ = 64 * jb_ + 4 * hi; \
        _Pragma("unroll") for (int r = 0; r < 16; ++r) { const int kv_ = kb_ + (r & 3) + 8 * (r >> 2); if (kv_ > qrel) C0[r] = -INFINITY; if (kv_ + 32 > qrel) C1[r] = -INFINITY; } } } while (0)
#define ROWMAX(C0, C1, i, rm) do { float a_ = MX3(C0[0], C0[1], C0[2]), b_ = MX3(C1[0], C1[1], C1[2]); \
        _Pragma("unroll") for (int r = 3; r < 15; r += 2) { a_ = MX3(a_, C0[r], C0[r + 1]); b_ = MX3(b_, C1[r], C1[r + 1]); } \
        a_ = __builtin_fmaxf(a_, C0[15]); b_ = __builtin_fmaxf(b_, C1[15]); const float kb0_ = KB0(i); \
        rm = xhalf_max(__builtin_fmaxf(a_ + kb0_, b_ + (kb0_ + sl2 * 32.0f))); } while (0)
    f32x16 pA0, pA1, pB0, pB1; bf16x8 kf0, kf1, kf2, kf3; s16x4 vl0, vl1, vl2, vl3, vh0, vh1, vh2, vh3; u32x4 pw0, pw1, pw2, pw3;
    float off0, off1;
#ifdef ATT_PRIO
    if (wid >= 4) __builtin_amdgcn_s_setprio(ATT_PRIO);
#endif
    if (n > 2) MIX_WAIT_BAR(6); else MIX_WAIT_BAR(4);
#define PKW(X, B) cvtpk(X[B], X[(B) + 1])
#define VFR(k) (bf16x8){vl##k[0], vl##k[1], vl##k[2], vl##k[3], vh##k[0], vh##k[1], vh##k[2], vh##k[3]}
#define VRD(k, f) do { if (VAR & 8) break; vl##k = vtr(vq_ + (((f) & 3) * 4096 + ((f) >> 2) * 1024)); vh##k = vtr(vq_ + (((f) & 3) * 4096 + ((f) >> 2) * 1024 + 512)); } while (0)
#define GAPA(MF, RD, A0, A1, A2, A3, W0, W1, PW) do { MF; RD; sacc += A0; sacc += A1; sacc += A2; sacc += A3; PIN(sacc); W0; W1; PIN(PW); SBAR(); } while (0)
#define GAPB(MF, RD, CI, X, B, OFF) do { MF; RD; CI; X[B] = EX2(X[B] + OFF); X[(B) + 1] = EX2(X[(B) + 1] + OFF); PIN(X); SBAR(); } while (0)
#define KRD(G, k, fo) do { if ((G) && !(VAR & 16)) { kf##k = kld(kn_ + (fo)); } } while (0)
#define STEP_DMA(i, GK, GV) do { if (GK) DMA_K((i) + 3, KSL((i) + 3)); if (GV) DMA_V((i) + 1, KSL((i) + 1)); } while (0)
#define STEP_A(C0, C1, P0, P1, i) do { SBAR(); const lds_cptr kq_ = kp0 + KSL(i), vq_ = vp0 + KSL((i) - 1); \
    float sacc = P0[0] + P0[1]; \
    GAPA(C0 = MFMA32(kf0, qr[0], C0), if (!(VAR & 16)) kf0 = kld(kq_ + 4096), P0[2], P0[3], P0[4], P0[5],     pw0[0] = PKW(P0, 0),  pw0[1] = PKW(P0, 2),  pw0); \
    GAPA(C1 = MFMA32(kf1, qr[0], C1), if (!(VAR & 16)) kf1 = kld(kq_ + 4608), P0[6], P0[7], P0[8], P0[9],     pw0[2] = PKW(P0, 4),  pw0[3] = PKW(P0, 6),  pw0); \
    GAPA(C0 = MFMA32(kf2, qr[1], C0),    if (!(VAR & 16)) kf2 = kld(kq_ + 6144), P0[10], P0[11], P0[12], P0[13], pw1[0] = PKW(P0, 8),  pw1[1] = PKW(P0, 10), pw1); \
    GAPA(C1 = MFMA32(kf3, qr[1], C1),    if (!(VAR & 16)) kf3 = kld(kq_ + 6656), P0[14], P0[15], P1[0], P1[1],   pw1[2] = PKW(P0, 12), pw1[3] = PKW(P0, 14), pw1); \
    GAPA(C0 = MFMA32(kf0, qr[2], C0),    VRD(0, 0),             P1[2], P1[3], P1[4], P1[5],     pw2[0] = PKW(P1, 0),  pw2[1] = PKW(P1, 2),  pw2); \
    GAPA(C1 = MFMA32(kf1, qr[2], C1),    VRD(1, 1),             P1[6], P1[7], P1[8], P1[9],     pw2[2] = PKW(P1, 4),  pw2[3] = PKW(P1, 6),  pw2); \
    GAPA(C0 = MFMA32(kf2, qr[3], C0),    VRD(2, 2),             P1[10], P1[11], P1[12], P1[13], pw3[0] = PKW(P1, 8),  pw3[1] = PKW(P1, 10), pw3); \
    GAPA(C1 = MFMA32(kf3, qr[3], C1),    VRD(3, 3),             P1[14], P1[15], 0.f, 0.f,       pw3[2] = PKW(P1, 12), pw3[3] = PKW(P1, 14), pw3); \
    l_reg += sacc; \
    } while (0)
#define STEP_D(C0, C1, i, MASKED) do { \
    if (MASKED) CMASK(C0, C1, i); \
    { float rm_; ROWMAX(C0, C1, i, rm_); resc = false; \
      if (__builtin_expect(__any(rm_ > mhat + THR), 0)) { const float mn_ = __builtin_fmaxf(mhat, rm_); fsc = EX2(mhat - mn_); l_reg *= fsc; mhat = mn_; resc = true; } \
      const float kb0_ = KB0(i); off0 = kb0_ - mhat; off1 = off0 + sl2 * 32.0f; } \
    SBAR(); } while (0)
#define STEP_B(C0, C1, P0, P1, i, GL) do { SBAR(); const lds_cptr kn_ = kp0 + KSL((i) + 1), vq_ = vp0 + KSL((i) - 1); \
    GAPB(ot[0] = MFMA32(VFR(0), __builtin_bit_cast(bf16x8, pw0), ot[0]), VRD(0, 4), (void)0,  C0, 0, off0); \
    GAPB(ot[1] = MFMA32(VFR(1), __builtin_bit_cast(bf16x8, pw0), ot[1]), VRD(1, 5), (void)0,  C0, 2, off0); \
    GAPB(ot[2] = MFMA32(VFR(2), __builtin_bit_cast(bf16x8, pw0), ot[2]), VRD(2, 6), CILD(P0, 0),  C0, 4, off0); \
    GAPB(ot[3] = MFMA32(VFR(3), __builtin_bit_cast(bf16x8, pw0), ot[3]), VRD(3, 7), CILD(P0, 1),  C0, 6, off0); \
    GAPB(ot[0] = MFMA32(VFR(0), __builtin_bit_cast(bf16x8, pw1), ot[0]), VRD(0, 8), CILD(P0, 2),  C0, 8, off0); \
    GAPB(ot[1] = MFMA32(VFR(1), __builtin_bit_cast(bf16x8, pw1), ot[1]), VRD(1, 9), CILD(P0, 3),  C0, 10, off0); \
    GAPB(ot[2] = MFMA32(VFR(2), __builtin_bit_cast(bf16x8, pw1), ot[2]), VRD(2, 10), CILD(P1, 0), C0, 12, off0); \
    GAPB(ot[3] = MFMA32(VFR(3), __builtin_bit_cast(bf16x8, pw1), ot[3]), VRD(3, 11), CILD(P1, 1), C0, 14, off0); \
    GAPB(ot[0] = MFMA32(VFR(0), __builtin_bit_cast(bf16x8, pw2), ot[0]), VRD(0, 12), CILD(P1, 2), C1, 0, off1); \
    GAPB(ot[1] = MFMA32(VFR(1), __builtin_bit_cast(bf16x8, pw2), ot[1]), VRD(1, 13), CILD(P1, 3), C1, 2, off1); \
    GAPB(ot[2] = MFMA32(VFR(2), __builtin_bit_cast(bf16x8, pw2), ot[2]), VRD(2, 14), (void)0, C1, 4, off1); \
    GAPB(ot[3] = MFMA32(VFR(3), __builtin_bit_cast(bf16x8, pw2), ot[3]), VRD(3, 15), (void)0, C1, 6, off1); \
    GAPB(ot[0] = MFMA32(VFR(0), __builtin_bit_cast(bf16x8, pw3), ot[0]), KRD(GL, 0, 0), (void)0,    C1, 8, off1); \
    GAPB(ot[1] = MFMA32(VFR(1), __builtin_bit_cast(bf16x8, pw3), ot[1]), KRD(GL, 1, 512), (void)0,  C1, 10, off1); \
    GAPB(ot[2] = MFMA32(VFR(2), __builtin_bit_cast(bf16x8, pw3), ot[2]), KRD(GL, 2, 2048), (void)0, C1, 12, off1); \
    GAPB(ot[3] = MFMA32(VFR(3), __builtin_bit_cast(bf16x8, pw3), ot[3]), KRD(GL, 3, 2560), (void)0, C1, 14, off1); \
    } while (0)
#define STEP_B0(C0, C1) do { SBAR(); _Pragma("unroll") for (int r = 0; r < 16; ++r) { C0[r] = EX2(C0[r] + off0); C1[r] = EX2(C1[r] + off1); } \
    kf0 = kld(kp0 + KSL(1)); kf1 = kld(kp0 + KSL(1) + 512); kf2 = kld(kp0 + KSL(1) + 2048); kf3 = kld(kp0 + KSL(1) + 2560); SBAR(); } while (0)
#define SYNC(i, LAST) do { if (!(LAST)) { ENDW(i); STEP_DMA((i) + 1, ((i) + 4 < n), ((i) + 2 < n)); } } while (0)
#define IT(C0, C1, P0, P1, i, GL, MASKED, LAST) do { STEP_A(C0, C1, P0, P1, i); STEP_D(C0, C1, i, MASKED); if (skw) SYNC(i, LAST); STEP_B(C0, C1, P0, P1, i, GL); RESC(); if (!skw) SYNC(i, LAST); } while (0)
#define ITS(C0, C1, P0, P1, i) do { STEP_A(C0, C1, P0, P1, i); STEP_D(C0, C1, i, false); if (skw) { MIX_WAIT_BAR(4); STEP_DMA((i) + 1, true, true); } STEP_B(C0, C1, P0, P1, i, true); RESC(); if (!skw) { MIX_WAIT_BAR(4); STEP_DMA((i) + 1, true, true); } } while (0)
#define RESC() do { if (resc) { _Pragma("unroll") for (int d_ = 0; d_ < 4; ++d_) _Pragma("unroll") for (int r = 0; r < 16; ++r) ot[d_][r] *= fsc; } } while (0)
#define ENDW(i) do { if ((i) + 3 < n) { MIX_WAIT_BAR(4); } else if ((i) + 2 < n) { MIX_WAIT_BAR(2); } else { MIX_WAIT_BAR(0); } } while (0)
    const bool skw = SKEW && (map == 1);
    STEP_DMA(0, (3 < n), true);
#pragma unroll
    for (int k = 0; k < 4; ++k) { CILD(pA0, k); CILD(pA1, k); CILD(pB0, k); CILD(pB1, k); }
    { const lds_cptr kb = kp0;
#pragma unroll
      for (int d0 = 0; d0 < 4; ++d0) { const bf16x8 k0 = kld(kb + d0 * 2048), k1 = kld(kb + d0 * 2048 + 512);
          pA0 = MFMA32(k0, qr[d0], pA0); pA1 = MFMA32(k1, qr[d0], pA1); } }
    CMASK(pA0, pA1, 0);
    { float rm; ROWMAX(pA0, pA1, 0, rm); mhat = rm; const float kb0_ = KB0(0); off0 = kb0_ - mhat; off1 = off0 + sl2 * 32.0f; }
    if (skw) SYNC(0, false);
#pragma unroll
    for (int r = 0; r < 16; ++r) { pA0[r] = EX2(pA0[r] + off0); pA1[r] = EX2(pA1[r] + off1); }
    if (!skw) SYNC(0, false);
    kf0 = kld(kp0 + KSL(1)); kf1 = kld(kp0 + KSL(1) + 512); kf2 = kld(kp0 + KSL(1) + 2048); kf3 = kld(kp0 + KSL(1) + 2560);
    int i = 1;
    for (; i + 5 < n; i += 2) { ITS(pB0, pB1, pA0, pA1, i); ITS(pA0, pA1, pB0, pB1, i + 1); }
    for (; i + 1 < n; i += 2) {
        IT(pB0, pB1, pA0, pA1, i, (i + 1 < n), true, false);
        IT(pA0, pA1, pB0, pB1, i + 1, (i + 2 < n), true, false);
    }
    IT(pB0, pB1, pA0, pA1, n - 1, false, true, true);
    { float sacc = pB0[0] + pB0[1];
#pragma unroll
      for (int r = 2; r < 16; ++r) sacc += pB0[r];
#pragma unroll
      for (int r = 0; r < 16; ++r) sacc += pB1[r];
      l_reg += sacc;
      pw0 = (u32x4){PKW(pB0, 0), PKW(pB0, 2), PKW(pB0, 4), PKW(pB0, 6)}; pw1 = (u32x4){PKW(pB0, 8), PKW(pB0, 10), PKW(pB0, 12), PKW(pB0, 14)};
      pw2 = (u32x4){PKW(pB1, 0), PKW(pB1, 2), PKW(pB1, 4), PKW(pB1, 6)}; pw3 = (u32x4){PKW(pB1, 8), PKW(pB1, 10), PKW(pB1, 12), PKW(pB1, 14)};
      const lds_cptr vb = vp0 + KSL(n - 1);
#pragma unroll
      for (int db = 0; db < 4; ++db) {
          { const s16x4 lo = vtr(vb + db * 4096), hh = vtr(vb + db * 4096 + 512); ot[db] = MFMA32(((bf16x8){lo[0], lo[1], lo[2], lo[3], hh[0], hh[1], hh[2], hh[3]}), __builtin_bit_cast(bf16x8, pw0), ot[db]); }
          { const s16x4 lo = vtr(vb + db * 4096 + 1024), hh = vtr(vb + db * 4096 + 1024 + 512); ot[db] = MFMA32(((bf16x8){lo[0], lo[1], lo[2], lo[3], hh[0], hh[1], hh[2], hh[3]}), __builtin_bit_cast(bf16x8, pw1), ot[db]); }
          { const s16x4 lo = vtr(vb + db * 4096 + 2048), hh = vtr(vb + db * 4096 + 2048 + 512); ot[db] = MFMA32(((bf16x8){lo[0], lo[1], lo[2], lo[3], hh[0], hh[1], hh[2], hh[3]}), __builtin_bit_cast(bf16x8, pw2), ot[db]); }
          { const s16x4 lo = vtr(vb + db * 4096 + 3072), hh = vtr(vb + db * 4096 + 3072 + 512); ot[db] = MFMA32(((bf16x8){lo[0], lo[1], lo[2], lo[3], hh[0], hh[1], hh[2], hh[3]}), __builtin_bit_cast(bf16x8, pw3), ot[db]); } } }
#ifdef ATT_PRIO
    __builtin_amdgcn_s_setprio(0);
#endif
    if (!band && dry) { MIX_WAIT_BAR(0); return; }
    const __amdgpu_buffer_rsrc_t srs = __builtin_amdgcn_make_buffer_rsrc((void*)slabs, 0, 256 * 8 * 17 * 1024, 0x00020000);
    if (!band) {
        const unsigned so = (unsigned)(((myw * 8 + wid) * 17 * 64 + lane) * 16);
#pragma unroll
        for (int d = 0; d < 4; ++d)
#pragma unroll
            for (int j = 0; j < 4; ++j) __builtin_amdgcn_raw_buffer_store_b128(__builtin_bit_cast(u32x4, (f32x4){ot[d][4 * j], ot[d][4 * j + 1], ot[d][4 * j + 2], ot[d][4 * j + 3]}), srs, so + (d * 4 + j) * 1024, 0, 16);
        __builtin_amdgcn_raw_buffer_store_b128(__builtin_bit_cast(u32x4, (f32x4){mhat, l_reg, 0.f, 0.f}), srs, so + 16 * 1024, 0, 16);
        MIX_WAIT_BAR(0);
        if (tid == 0) __hip_atomic_store(flags + myw * 16, epoch, __ATOMIC_RELAXED, __HIP_MEMORY_SCOPE_AGENT);
        return;
    }
    if (!dry) for (int pw = pw_lo; pw < pw_hi; ++pw) {
        if (wid == 0) { unsigned spins = 0;
            while (__hip_atomic_load(flags + pw * 16, __ATOMIC_RELAXED, __HIP_MEMORY_SCOPE_AGENT) != epoch) { __builtin_amdgcn_s_sleep(2); if (++spins > (1u << 22)) break; } }
        MIX_WAIT_BAR(0);
        const unsigned so = (unsigned)(((pw * 8 + wid) * 17 * 64 + lane) * 16);
        const f32x4 ml = __builtin_bit_cast(f32x4, __builtin_amdgcn_raw_buffer_load_b128(srs, so + 16 * 1024, 0, 16));
        f32x4 po[16];
#pragma unroll
        for (int k = 0; k < 16; ++k) po[k] = __builtin_bit_cast(f32x4, __builtin_amdgcn_raw_buffer_load_b128(srs, so + k * 1024, 0, 16));
        const float mn = fmaxf(mhat, ml[0]), f0 = EX2(mhat - mn), f1 = EX2(ml[0] - mn);
        l_reg = l_reg * f0 + ml[1] * f1; mhat = mn;
#pragma unroll
        for (int d = 0; d < 4; ++d)
#pragma unroll
            for (int j = 0; j < 4; ++j)
#pragma unroll
                for (int e = 0; e < 4; ++e) ot[d][4 * j + e] = ot[d][4 * j + e] * f0 + po[d * 4 + j][e] * f1;
    }
    l_reg = xhalf_sum(l_reg);
    MIX_WAIT_BAR(0);
    __attribute__((address_space(3))) float* xw = (__attribute__((address_space(3))) float*)(lds + A_LDS_X) + qw * 4096 + lane;
    if (map == 1) {
        const float sc = lam / l_reg;
#pragma unroll
        for (int d = 0; d < 4; ++d)
#pragma unroll
            for (int r = 0; r < 16; ++r) xw[(d * 16 + r) * 64] = ot[d][r] * sc;
    }
    MIX_WAIT_BAR(0);
    if (map == 0 && dry == 0) {
        const float sc = 1.0f / l_reg; float ss = 0.f;
#pragma unroll
        for (int d = 0; d < 4; ++d)
#pragma unroll
            for (int r = 0; r < 16; ++r) { const float o = ot[d][r] * sc - xw[(d * 16 + r) * 64]; ot[d][r] = o; ss += o * o; }
        ss = xhalf_sum(ss);
        const float rn = __builtin_amdgcn_rsqf(ss * (1.0f / 128.0f) + EPS);
        const long row = rowbase + q0 + qw * 32 + r32;
        const bf16* gp = P + row * PITCH + PC_G + 256 + h * 128 + 4 * hi;
        bf16* yp = Y + row * 1024 + 256 + h * 128 + 4 * hi;
#pragma unroll
        for (int d = 0; d < 4; ++d)
#pragma unroll
            for (int rq = 0; rq < 4; ++rq) {
                const u32x2 g = *(const u32x2*)(gp + d * 32 + rq * 8);
                const float g0 = __uint_as_float(g.x << 16), g1 = __uint_as_float(g.x & 0xffff0000u), g2 = __uint_as_float(g.y << 16), g3 = __uint_as_float(g.y & 0xffff0000u);
                u32x2 w; w.x = cvtpk(ot[d][rq * 4 + 0] * rn * g0, ot[d][rq * 4 + 1] * rn * g1); w.y = cvtpk(ot[d][rq * 4 + 2] * rn * g2, ot[d][rq * 4 + 3] * rn * g3);
                *(u32x2*)(yp + d * 32 + rq * 8) = w; }
    }
    MIX_WAIT_BAR(0);
#undef DMA_K
#undef CILD
#undef DMA_V
#undef KSL
#undef KB0
#undef CMASK
#undef ROWMAX
#undef PKW
#undef VFR
#undef VRD
#undef GAPA
#undef GAPB
#undef KRD
#undef STEP_DMA
#undef STEP_A
#undef STEP_D
#undef STEP_B
#undef STEP_B0
#undef IT
#undef ITS
#undef SYNC
#undef RESC
#undef ENDW
}

constexpr float SKIP_T = 40.0f;
#ifndef A_OVH
#define A_OVH 2
#endif
#ifndef A_W3
#define A_W3 9
#endif
#ifndef A_W2
#define A_W2 8
#endif
constexpr int A_LDS_SCH = 148 * 1024;
template <int VAR> __device__ __forceinline__ void attn_phase(int l, int w, const unsigned* nrm, float* slabs, unsigned* flags, const bf16* __restrict__ P, const bf16* __restrict__ KT, const bf16* __restrict__ VT, bf16* __restrict__ Y, float lam, lds_ptr lds, int dry) {
    int tid_ = threadIdx.x; asm volatile("" : "+v"(tid_));
    const int tid = tid_, lane = tid & 63; const int wid = __builtin_amdgcn_readfirstlane(tid >> 6);
    __attribute__((address_space(3))) int* costs = (__attribute__((address_space(3))) int*)(lds + A_LDS_SCH);
    __attribute__((address_space(3))) int* pres = costs + 512;
    __attribute__((address_space(3))) int* wsum = pres + 512;
    int cost;
    { const int u = tid, bh = u >> 6, qb = u & 63, b = bh >> 2, h = bh & 3;
      const unsigned* nq = nrm + (b * 2 + 0) * 16 + h * 4; const unsigned* nk = nrm + (b * 2 + 1) * 16 + h * 4;
      const float a0 = (__uint_as_float(nq[0]) + __uint_as_float(nq[1])) * (__uint_as_float(nk[0]) + __uint_as_float(nk[1]));
      const float a1 = (__uint_as_float(nq[2]) + __uint_as_float(nq[3])) * (__uint_as_float(nk[2]) + __uint_as_float(nk[3]));
      const float nqk = sqrtf(fmaxf(a0, a1)) * 1.01f;
      const float sl2 = exp2f(-2.0f * (float)(h + 1)) * LOG2E;
      const float D = (2.0f * nqk + SKIP_T) / sl2;
      const int NT = 2 * (qb + 1);
      const float lim = (float)(128 * qb) - D - 63.0f;
      int t_lo = (lim >= 0.f) ? ((int)floorf(lim * (1.0f / 64.0f)) + 1) : 0;
      t_lo &= ~1; if (t_lo > NT - 2) t_lo = NT - 2; if (t_lo < 0) t_lo = 0;
      if (VAR & 4) t_lo = 0;
      cost = (NT - t_lo) >> 1; }
    const int wgt = ((tid >> 6) & 3) == 3 ? A_W3 : ((tid >> 6) & 3) == 2 ? A_W2 : 8;
    const int vcost = cost * wgt + 8 * A_OVH;
    int incl = vcost;
#pragma unroll
    for (int o = 1; o < 64; o <<= 1) { const int v = __shfl_up(incl, o); if (lane >= o) incl += v; }
    if (lane == 63) wsum[wid] = incl;
    __syncthreads();
    int base = 0, total = 0;
#pragma unroll
    for (int k = 0; k < 8; ++k) { const int v = wsum[k]; if (k < wid) base += v; total += v; }
    const int pre = base + incl - vcost;
    costs[tid] = cost; pres[tid] = pre;
    const int lo = (int)(((long)w * total) >> 8), hi = (int)(((long)(w + 1) * total) >> 8);
    if (pre <= lo && lo < pre + vcost) wsum[8] = tid;
    if (pre < hi && hi <= pre + vcost) wsum[9] = tid;
    __syncthreads();
    const int u_first = wsum[8], u_last = wsum[9];
    const unsigned epoch = (unsigned)l + 1u;
    for (int u = u_last; u >= u_first; --u) {
        const int c = costs[u], p0 = pres[u], bh = u >> 6, qb = u & 63, NT = 2 * (qb + 1), t0 = NT - 2 * c;
        const int W = (bh & 3) == 3 ? A_W3 : (bh & 3) == 2 ? A_W2 : 8, L = c * W + 8 * A_OVH;
        const int vlo = (lo > p0 ? lo : p0) - p0, vhi = (hi < p0 + L ? hi : p0 + L) - p0;
        const int s_lo = vlo > 8 * A_OVH ? (vlo - 8 * A_OVH) / W : 0, s_hi = vhi > 8 * A_OVH ? (vhi - 8 * A_OVH) / W : 0;
        if (s_hi <= s_lo) continue;
        int pw_lo = w;
        if (s_hi == c && s_lo > 0) { while (pw_lo > 0 && (int)(((long)pw_lo * total) >> 8) >= p0 + 8 * A_OVH + W) --pw_lo; }
        attn_unit<VAR>(bh >> 2, bh & 3, qb, t0 + 2 * s_lo, t0 + 2 * s_hi, pw_lo, w, w, epoch, slabs, flags, P, KT, VT, Y, lam, lds, dry);
    }
    __syncthreads();
}
__device__ __forceinline__ void conv_unit(int unit, const bf16* __restrict__ P, bf16* __restrict__ Y, const float* __restrict__ cw, const float* __restrict__ cb, const float* __restrict__ lg, const float* __restrict__ lb, lds_ptr lds) {
    int tid_ = threadIdx.x; asm volatile("" : "+v"(tid_));
    const int tid = tid_, lane = tid & 63; const int wid = __builtin_amdgcn_readfirstlane(tid >> 6);
    const int t0 = unit * 64; const bool first = (t0 & (SEQ - 1)) == 0;
    __attribute__((address_space(3))) float* zb = (__attribute__((address_space(3))) float*)lds;
    const f32x4 g4 = *(const f32x4*)(lg + 4 * lane), b4 = *(const f32x4*)(lb + 4 * lane);
    u32x2 gpre[8];
#pragma unroll
    for (int i = 0; i < 8; ++i) gpre[i] = *(const u32x2*)(P + (long)(t0 + wid * 8 + i) * PITCH + PC_G + 4 * lane);
#pragma unroll
    for (int k = 0; k < 6; ++k) { const int id = tid + 512 * k;
        if (id < 94 * 32) { const int row = id >> 5, c8 = id & 31; u32x4 v = (u32x4){0u, 0u, 0u, 0u};
            if (!(first && row < 30)) v = *(const u32x4*)(P + (long)(t0 - 30 + row) * PITCH + PC_Z + c8 * 8);
            f32x4 a, b; a[0] = __uint_as_float(v.x << 16); a[1] = __uint_as_float(v.x & 0xffff0000u); a[2] = __uint_as_float(v.y << 16); a[3] = __uint_as_float(v.y & 0xffff0000u);
            b[0] = __uint_as_float(v.z << 16); b[1] = __uint_as_float(v.z & 0xffff0000u); b[2] = __uint_as_float(v.w << 16); b[3] = __uint_as_float(v.w & 0xffff0000u);
            *(__attribute__((address_space(3))) f32x4*)(zb + row * 256 + c8 * 8) = a; *(__attribute__((address_space(3))) f32x4*)(zb + row * 256 + c8 * 8 + 4) = b; } }
    __syncthreads();
    const int c = tid & 255, half = tid >> 8;
    float acc[32];
    { const float bias = cb[c];
#pragma unroll
      for (int t = 0; t < 32; ++t) acc[t] = bias; }
    { float zr[62];
#pragma unroll
      for (int i = 0; i < 62; ++i) zr[i] = zb[(half * 32 + i) * 256 + c];
#pragma unroll
      for (int j = 0; j < CONV_W; ++j) { const float w = cw[j * D_CONV + c];
#pragma unroll
          for (int t = 0; t < 32; ++t) acc[t] = fmaf(w, zr[t + j], acc[t]); } }
    __syncthreads();
#pragma unroll
    for (int t = 0; t < 32; ++t) zb[(half * 32 + t) * 256 + c] = acc[t];
    __syncthreads();
    { f32x4 vv[8]; float s1[8], s2[8];
#pragma unroll
      for (int i = 0; i < 8; ++i) { vv[i] = *(const __attribute__((address_space(3))) f32x4*)(zb + (wid * 8 + i) * 256 + 4 * lane);
          s1[i] = (vv[i][0] + vv[i][1]) + (vv[i][2] + vv[i][3]); s2[i] = (vv[i][0] * vv[i][0] + vv[i][1] * vv[i][1]) + (vv[i][2] * vv[i][2] + vv[i][3] * vv[i][3]); }
#pragma unroll
      for (int i = 0; i < 8; ++i) { s1[i] = wave_sum(s1[i]); s2[i] = wave_sum(s2[i]); }
#pragma unroll
      for (int i = 0; i < 8; ++i) { const long t = t0 + wid * 8 + i;
          const float mean = s1[i] * (1.0f / 256.0f), var = fmaxf(s2[i] * (1.0f / 256.0f) - mean * mean, 0.f);
          const float rstd = __builtin_amdgcn_rsqf(var + EPS);
          const u32x2 g = gpre[i];
          const float gg[4] = {__uint_as_float(g.x << 16), __uint_as_float(g.x & 0xffff0000u), __uint_as_float(g.y << 16), __uint_as_float(g.y & 0xffff0000u)};
          float o[4];
#pragma unroll
          for (int e = 0; e < 4; ++e) { const float yv = (vv[i][e] - mean) * rstd * g4[e] + b4[e]; o[e] = yv * __builtin_amdgcn_rcpf(1.0f + __builtin_amdgcn_exp2f(-LOG2E * yv)) * gg[e]; }
          u32x2 w; w.x = cvtpk(o[0], o[1]); w.y = cvtpk(o[2], o[3]);
          *(u32x2*)(Y + t * 1024 + 4 * lane) = w; } }
    __syncthreads();
}
__device__ __forceinline__ void sgu_unit(int unit, const bf16* __restrict__ P, bf16* __restrict__ Y, const bf16* __restrict__ wst, const float* __restrict__ bs, const float* __restrict__ lg, const float* __restrict__ lb, lds_ptr lds) {
    int tid_ = threadIdx.x; asm volatile("" : "+v"(tid_));
    const int tid = tid_, lane = tid & 63; const int wid = __builtin_amdgcn_readfirstlane(tid >> 6);
    const int chunk = unit >> 1, gp = unit & 1; const long t0 = (long)chunk * 128;
    constexpr int VS = 136;
    __attribute__((address_space(3))) unsigned short* vt = (__attribute__((address_space(3))) unsigned short*)lds;
    const int tq = lane & 15, kq = lane >> 4;
    const int nks = (16 * wid + 15) / 32 + 1;
    bf16x8 wf[4][2];
#pragma unroll
    for (int ks = 0; ks < 4; ++ks)
#pragma unroll
        for (int g2 = 0; g2 < 2; ++g2) wf[ks][g2] = (ks < nks) ? *(const bf16x8*)(wst + ((size_t)(2 * gp + g2) * 128 + 16 * wid + tq) * 128 + 32 * ks + 8 * kq) : (bf16x8){0, 0, 0, 0, 0, 0, 0, 0};
    const int tl = 16 * wid + tq; const long t = t0 + tl;
    u32x2 upre[2][4], gpre[2][4]; float bsv2[2];
#pragma unroll
    for (int g2 = 0; g2 < 2; ++g2) { const int g = 2 * gp + g2; bsv2[g2] = bs[g * 128 + tl];
#pragma unroll
        for (int db = 0; db < 4; ++db) { const int ch = g * 64 + db * 16 + 4 * kq; upre[g2][db] = *(const u32x2*)(P + t * PITCH + PC_U + ch); gpre[g2][db] = *(const u32x2*)(P + t * PITCH + PC_G + 768 + ch); } }
    { const f32x4 g4 = *(const f32x4*)(lg + 4 * lane), b4 = *(const f32x4*)(lb + 4 * lane);
      u32x2 rawv[16];
#pragma unroll
      for (int i = 0; i < 16; ++i) rawv[i] = *(const u32x2*)(P + (t0 + wid * 16 + i) * PITCH + PC_VV + 4 * lane);
      float s1[16], s2[16];
#pragma unroll
      for (int i = 0; i < 16; ++i) { const u32x2 raw = rawv[i];
          const float a0 = __uint_as_float(raw.x << 16), a1 = __uint_as_float(raw.x & 0xffff0000u), a2 = __uint_as_float(raw.y << 16), a3 = __uint_as_float(raw.y & 0xffff0000u);
          s1[i] = (a0 + a1) + (a2 + a3); s2[i] = (a0 * a0 + a1 * a1) + (a2 * a2 + a3 * a3); }
#pragma unroll
      for (int i = 0; i < 16; ++i) { s1[i] = wave_sum(s1[i]); s2[i] = wave_sum(s2[i]); }
      if ((lane >> 5) == gp) { const int cl = 4 * (lane & 31);
#pragma unroll
          for (int i = 0; i < 16; ++i) { const int tl = wid * 16 + i; const u32x2 raw = rawv[i];
              const float mean = s1[i] * (1.0f / 256.0f), var = fmaxf(s2[i] * (1.0f / 256.0f) - mean * mean, 0.f), rstd = __builtin_amdgcn_rsqf(var + EPS);
              const float a[4] = {__uint_as_float(raw.x << 16), __uint_as_float(raw.x & 0xffff0000u), __uint_as_float(raw.y << 16), __uint_as_float(raw.y & 0xffff0000u)};
#pragma unroll
              for (int e = 0; e < 4; ++e) vt[(cl + e) * VS + tl] = (unsigned short)(cvtpk((a[e] - mean) * rstd * g4[e] + b4[e], 0.f) & 0xffffu); } } }
    __syncthreads();
    f32x4 acc[2][4];
#pragma unroll
    for (int g2 = 0; g2 < 2; ++g2)
#pragma unroll
        for (int db = 0; db < 4; ++db) acc[g2][db] = (f32x4){0.f, 0.f, 0.f, 0.f};
#pragma unroll
    for (int ks = 0; ks < 4; ++ks) if (ks < nks) {
#pragma unroll
        for (int g2 = 0; g2 < 2; ++g2) {
#pragma unroll
            for (int db = 0; db < 4; ++db) {
                const bf16x8 vf = *(const __attribute__((address_space(3))) bf16x8*)(vt + (g2 * 64 + db * 16 + tq) * VS + 32 * ks + 8 * kq);
                acc[g2][db] = __builtin_amdgcn_mfma_f32_16x16x32_bf16(vf, wf[ks][g2], acc[g2][db], 0, 0, 0); } } }
#pragma unroll
    for (int g2 = 0; g2 < 2; ++g2) { const int g = 2 * gp + g2; const float bsv = bsv2[g2];
#pragma unroll
        for (int db = 0; db < 4; ++db) { const int ch = g * 64 + db * 16 + 4 * kq;
            const u32x2 u = upre[g2][db], gt = gpre[g2][db];
            const float uu[4] = {__uint_as_float(u.x << 16), __uint_as_float(u.x & 0xffff0000u), __uint_as_float(u.y << 16), __uint_as_float(u.y & 0xffff0000u)};
            const float gg[4] = {__uint_as_float(gt.x << 16), __uint_as_float(gt.x & 0xffff0000u), __uint_as_float(gt.y << 16), __uint_as_float(gt.y & 0xffff0000u)};
            u32x2 w; w.x = cvtpk((acc[g2][db][0] + bsv) * uu[0] * gg[0], (acc[g2][db][1] + bsv) * uu[1] * gg[1]); w.y = cvtpk((acc[g2][db][2] + bsv) * uu[2] * gg[2], (acc[g2][db][3] + bsv) * uu[3] * gg[3]);
            *(u32x2*)(Y + t * 1024 + 768 + ch) = w; } }
    __syncthreads();
}
}
#ifndef REP_CS
#define REP_CS 1
#endif
#ifndef STATIC_CONV
#define STATIC_CONV 0
#endif
#ifndef ATT_VAR
#define ATT_VAR 0
#endif
#ifndef DRY_VAR
#define DRY_VAR -1
#endif
#ifndef MIX_ATTN
#define MIX_ATTN 1
#endif
#ifndef MIX_CONV
#define MIX_CONV 1
#endif
#ifndef MIX_SGU
#define MIX_SGU 1
#endif
#define RUN_QUEUE(lq, maxn) do { const int lyr_ = (lq) & 1; volatile LAS int* qs_ = (volatile LAS int*)(F.lds + RING_OFF + mix::A_LDS_SCH + 4096 + 64); \
        for (int qn_ = 0; qn_ < (maxn); ++qn_) { __syncthreads(); if (F.tid == 0) qs_[0] = (int)__hip_atomic_fetch_add((unsigned*)(F.ctl + CW_QUEUE) + 16 * (lq), 1u, __ATOMIC_RELAXED, __HIP_MEMORY_SCOPE_AGENT); __syncthreads(); \
            const int qi_ = qs_[0] + (STATIC_CONV ? 256 : 0); if (qi_ >= 512) break; \
            if (qi_ < 256) mix::conv_unit(qi_, (const bf16*)(ws + WS_PROJ), (bf16*)(ws + WS_Y), args.in[I_CONVW] + lyr_ * CONV_W * D_CONV, args.in[I_CONVB] + lyr_ * D_CONV, args.in[I_CLNG] + lyr_ * D_CONV, args.in[I_CLNB] + lyr_ * D_CONV, F.lds + RING_OFF); \
            else mix::sgu_unit(qi_ - 256, (const bf16*)(ws + WS_PROJ), (bf16*)(ws + WS_Y), (const bf16*)(ws + WS_WST) + (size_t)lyr_ * NG * CHUNK * CHUNK, args.in[I_BS] + lyr_ * NG * CHUNK, args.in[I_SLNG] + lyr_ * D_SGU, args.in[I_SLNB] + lyr_ * D_SGU, F.lds + RING_OFF); } } while (0)
#if STATIC_CONV
#define QUEUE_PROLOG(l) mix::conv_unit(F.vcu, (const bf16*)(ws + WS_PROJ), (bf16*)(ws + WS_Y), args.in[I_CONVW] + (l) * CONV_W * D_CONV, args.in[I_CONVB] + (l) * D_CONV, args.in[I_CLNG] + (l) * D_CONV, args.in[I_CLNB] + (l) * D_CONV, F.lds + RING_OFF)
#else
#define QUEUE_PROLOG(l) do { } while (0)
#endif
#define MIXERS_PHASE(l) do { \
    if (MIX_ATTN) { \
        float s1_ = 0.f, s2_ = 0.f; for (int i_ = 0; i_ < QKD; ++i_) { s1_ += args.in[I_LQ1][(l) * QKD + i_] * args.in[I_LK1][(l) * QKD + i_]; s2_ += args.in[I_LQ2][(l) * QKD + i_] * args.in[I_LK2][(l) * QKD + i_]; } \
        const float lam_init_ = 0.8f - 0.6f * __expf(-0.3f * (float)(l)); const float lam_ = __expf(s1_) - __expf(s2_) + lam_init_; \
        mix::attn_phase<ATT_VAR>((l), F.vcu, (const unsigned*)(F.ctl + CW_NRM) + (l) * 64, (float*)(ws + WS_SLAB), (unsigned*)(F.ctl + CW_FLAG), (const bf16*)(ws + WS_PROJ), (const bf16*)(ws + WS_KT), (const bf16*)(ws + WS_VT), (bf16*)(ws + WS_Y), lam_, F.lds + RING_OFF, 0); \
        if (DRY_VAR >= 0) mix::attn_phase<(DRY_VAR < 0 ? 0 : DRY_VAR)>((l), F.vcu, (const unsigned*)(F.ctl + CW_NRM) + (l) * 64, (float*)(ws + WS_SLAB), (unsigned*)(F.ctl + CW_FLAG), (const bf16*)(ws + WS_PROJ), (const bf16*)(ws + WS_KT), (const bf16*)(ws + WS_VT), (bf16*)(ws + WS_Y), lam_, F.lds + RING_OFF, args.dry); } \
    STAMP(10 + 4 * (l)); \
    if (MIX_CONV && MIX_SGU) { QUEUE_PROLOG(l); RUN_QUEUE(l, 1024); for (int rq_ = 1; rq_ < REP_CS; ++rq_) { RUN_QUEUE((l) + 2 * rq_, 1024); } } \
    else { if (MIX_CONV) mix::conv_unit(F.vcu, (const bf16*)(ws + WS_PROJ), (bf16*)(ws + WS_Y), args.in[I_CONVW] + (l) * CONV_W * D_CONV, args.in[I_CONVB] + (l) * D_CONV, args.in[I_CLNG] + (l) * D_CONV, args.in[I_CLNB] + (l) * D_CONV, F.lds + RING_OFF); \
        if (MIX_SGU) mix::sgu_unit(F.vcu, (const bf16*)(ws + WS_PROJ), (bf16*)(ws + WS_Y), (const bf16*)(ws + WS_WST) + (size_t)(l) * NG * CHUNK * CHUNK, args.in[I_BS] + (l) * NG * CHUNK, args.in[I_SLNG] + (l) * D_SGU, args.in[I_SLNB] + (l) * D_SGU, F.lds + RING_OFF); } \
    } while (0)

constexpr size_t MiB = 1u << 20;
constexpr size_t WS_CTL = 0, CTL_ZERO_BYTES = 64 * 1024;
constexpr size_t WS_SSQP = 1 * MiB;
constexpr size_t WS_XCHG = 1 * MiB + 512 * 1024;
constexpr size_t WS_WST = 2 * MiB;
constexpr size_t WS_WIN = 4 * MiB;
constexpr size_t WS_WOUT = 18 * MiB;
constexpr size_t WS_XB = 22 * MiB;
constexpr size_t WS_PROJ = 54 * MiB;
constexpr size_t WS_KT = 126 * MiB, WS_VT = 142 * MiB;
constexpr size_t WS_Y = 166 * MiB;
constexpr size_t WS_DBG_D = 198 * MiB;
constexpr size_t WS_SLAB = 198 * MiB;
constexpr size_t WS_DBG_VV = 236 * MiB;
constexpr int CW_NRM = 8192;
constexpr int CW_R1 = 13632;
constexpr int CW_QUEUE = 13568;
constexpr int CW_PANEL = 12544;
constexpr int CW_FLAG = 8448;
constexpr int CW_BAR = 4096;
static_assert((CW_BAR + 3456) <= CW_NRM && (CW_FLAG + 256 * 16) <= CW_PANEL && (CW_PANEL + 64 * 16) <= CW_QUEUE && (CW_QUEUE + 4 * 16) <= CW_R1 && (CW_R1 + 2 * 16) * 4 <= (int)CTL_ZERO_BYTES, "CTL words inside the memset region");

constexpr int RING_OFF = 0, RING_BYTES = 159744;
constexpr int LDSCTL_OFF = RING_BYTES, MISC_OFF = LDSCTL_OFF + 320;
constexpr int LDS_BYTES = 163840;
constexpr int NWAVES = 8;

struct Args {
    const float* in[18]; float* out; unsigned char* ws; int ph_lo, ph_hi, dry, pad;
};
enum { I_X = 0, I_NORMG, I_WIN, I_CONVW, I_CONVB, I_CLNG, I_CLNB, I_LQ1, I_LK1, I_LQ2, I_LK2, I_SUBG, I_SLNG, I_SLNB, I_WS, I_BS, I_WOUT, I_NORMF };

__device__ __forceinline__ float wave_sum(float x) { return mix::wave_sum(x); }
__device__ __forceinline__ float bf2f(unsigned short v) { return __uint_as_float((unsigned)v << 16); }

__host__ __device__ __forceinline__ int win_colmap(int np) { const int pt = np >> 8, j = np & 255;
    switch (pt) { case 0: case 1: return (j < 128) ? (128 * pt + j) : (256 + 128 * pt + (j - 128));
        case 2: return 2048 + j; case 3: return 2304 + j; case 4: return 2560 + j; case 5: return 2560 + 768 + j;
        case 6: case 7: return 512 + (pt - 6) * 256 + j; case 8: case 9: return 1024 + (pt - 8) * 256 + j; case 10: case 11: return 1536 + (pt - 10) * 256 + j;
        default: return 2560 + 256 + (pt - 12) * 256 + j; } }

__device__ __forceinline__ void p0_transpose_item(const float* W, int K, int N, bf16* WT, const float* gain, bool permute, LAS float* scr, int item, int lane, float hscale = 0.f) {
    const int nblk = N / 32, kb = item / nblk, nb = item % nblk, k0 = 64 * kb, n0 = 32 * nb;
    const int s0 = permute ? win_colmap(n0) : n0;
    float wv[32];
#pragma unroll
    for (int i = 0; i < 32; ++i) wv[i] = W[(size_t)(k0 + 2 * i + (lane >> 5)) * N + s0 + (lane & 31)];
#pragma unroll
    for (int i = 0; i < 32; ++i) { const int kk = 2 * i + (lane >> 5); float v = wv[i]; if (hscale != 0.f) { const int k_ = k0 + kk; if (k_ >= 256 && k_ < 768) v *= gain[k_ & 127] * hscale; } else if (gain) v *= gain[k0 + kk]; scr[kk * 33 + (lane & 31)] = v; }
    LDS_WAIT(); asm volatile("" ::: "memory");
    const int c = lane & 7;
#pragma unroll
    for (int j = 0; j < 4; ++j) { const int n = (lane >> 3) + 8 * j; const LAS float* s = scr + (8 * c) * 33 + n;
        v4u o; o.x = pk2(s[0 * 33], s[1 * 33]); o.y = pk2(s[2 * 33], s[3 * 33]); o.z = pk2(s[4 * 33], s[5 * 33]); o.w = pk2(s[6 * 33], s[7 * 33]);
        *(GAS v4u*)(WT + (size_t)(n0 + n) * K + k0 + 8 * c) = o; }
    LDS_WAIT(); asm volatile("" ::: "memory");
}

struct Frame {
    LAS unsigned char* lds;
    volatile LAS unsigned* MISC;
    gu32* ctl;
    int tid, lane, wave, vcu, G;
};

__device__ __forceinline__ void p0_prologue(Frame& F, const Args& a) {
    int lane_ = F.lane; asm volatile("" : "+v"(lane_));
    LAS float* scr = (LAS float*)(F.lds + RING_OFF + F.wave * 16384);
    const int gw = F.vcu * NWAVES + F.wave, NGW = F.G * NWAVES;
    unsigned char* ws = a.ws;
    constexpr int I_IN = (D_MODEL / 64) * (D_IN / 32);
    for (int it = gw; it < I_IN; it += NGW)
        p0_transpose_item(a.in[I_WIN], D_MODEL, D_IN, (bf16*)(ws + WS_WIN), a.in[I_NORMG], true, scr, it, lane_);
    { bf16* wst = (bf16*)(ws + WS_WST); const float* w = a.in[I_WS];
      for (int i = gw * 64 + lane_; i < DEPTH * NG * CHUNK * CHUNK; i += NGW * 64) { const int s = i & 127, t = (i >> 7) & 127; wst[i] = (bf16)f2bf(s <= t ? w[i] : 0.f); } }
    { const float* x = a.in[I_X]; bf16* xb = (bf16*)(ws + WS_XB); float* ssqp = (float*)(ws + WS_SSQP);
      for (int m = gw; m < M_TOK; m += 4 * NGW) {
          f32x4 v[4][4]; float s[4];
#pragma unroll
          for (int r = 0; r < 4; ++r) { const GAS f32x4* xr = (const GAS f32x4*)(x + (size_t)(m + r * NGW) * D_MODEL) + lane_;
#pragma unroll
              for (int j = 0; j < 4; ++j) v[r][j] = xr[64 * j]; }
#pragma unroll
          for (int r = 0; r < 4; ++r) { float t = 0.f;
#pragma unroll
              for (int j = 0; j < 4; ++j) t += (v[r][j].x * v[r][j].x + v[r][j].y * v[r][j].y) + (v[r][j].z * v[r][j].z + v[r][j].w * v[r][j].w);
              s[r] = wave_sum(t); }
#pragma unroll
          for (int r = 0; r < 4; ++r) { GAS unsigned long long* o8 = (GAS unsigned long long*)(xb + (size_t)(m + r * NGW) * D_MODEL) + lane_;
#pragma unroll
              for (int j = 0; j < 4; ++j) o8[64 * j] = (unsigned long long)pk2(v[r][j].x, v[r][j].y) | ((unsigned long long)pk2(v[r][j].z, v[r][j].w) << 32);
              if (lane_ < 4) ssqp[(size_t)lane_ * M_TOK + m + r * NGW] = (lane_ == 0) ? s[r] : 0.f; }
      } }
}
__device__ __forceinline__ void late_convert(Frame& F, const Args& a, int rank, int nwg) {
    int lane_ = F.lane; asm volatile("" : "+v"(lane_));
    LAS float* scr = (LAS float*)(F.lds + RING_OFF + F.wave * 16384);
    const int gw = rank * NWAVES + F.wave, NGW = nwg * NWAVES;
    unsigned char* ws = a.ws;
    constexpr int I_IN = (D_MODEL / 64) * (D_IN / 32), I_OUT = (D_MIX / 64) * (D_MODEL / 32);
    for (int it = gw; it < I_IN + 2 * I_OUT; it += NGW) {
        int r = it;
        if (r < I_IN) { p0_transpose_item(a.in[I_WIN] + (size_t)D_MODEL * D_IN, D_MODEL, D_IN, (bf16*)(ws + WS_WIN) + (size_t)D_IN * D_MODEL, a.in[I_NORMG] + D_MODEL, true, scr, r, lane_); continue; }
        r -= I_IN;
        { const int l = r / I_OUT; r -= l * I_OUT;
            p0_transpose_item(a.in[I_WOUT] + (size_t)l * D_MIX * D_MODEL, D_MIX, D_MODEL, (bf16*)(ws + WS_WOUT) + (size_t)l * D_MODEL * D_MIX, a.in[I_SUBG] + l * VD, false, scr, r, lane_, 1.0f - (0.8f - 0.6f * __expf(-0.3f * (float)l))); }
    }
}

__device__ __forceinline__ void final_norm(Frame& F, const Args& a) {
    const int gw = F.vcu * NWAVES + F.wave, NGW = F.G * NWAVES;
    const GAS f32x4* g4 = (const GAS f32x4*)a.in[I_NORMF] + F.lane;
    for (int m = gw; m < M_TOK; m += NGW) {
        GAS f32x4* xr = (GAS f32x4*)(a.out + (size_t)m * D_MODEL) + F.lane;
        f32x4 v[4]; float s = 0.f;
#pragma unroll
        for (int j = 0; j < 4; ++j) { v[j] = xr[64 * j]; s += (v[j].x * v[j].x + v[j].y * v[j].y) + (v[j].z * v[j].z + v[j].w * v[j].w); }
        s = wave_sum(s);
        const float r = 1.0f / sqrtf(s * (1.0f / D_MODEL) + EPS);
#pragma unroll
        for (int j = 0; j < 4; ++j) xr[64 * j] = v[j] * r * g4[64 * j];
    }
}

#ifndef EARLY0
#define EARLY0 1
#endif
#ifndef EARLY1
#define EARLY1 2
#endif
#define EARLY_UNITS(l) ((l) == 0 ? EARLY0 : EARLY1)
#ifndef REP_PRO
#define REP_PRO 1
#endif
#ifndef REP_OUT0
#define REP_OUT0 1
#endif
#ifndef REP_IN
#define REP_IN 1
#endif
#ifndef REP_MIX
#define REP_MIX 1
#endif
constexpr int N_PHASES = 8;
__global__ void __launch_bounds__(NWAVES * 64, 2) mk_fwd(Args args) {
    extern __shared__ __attribute__((aligned(16))) unsigned char lds[];
    Frame F;
    F.lds = (LAS unsigned char*)lds;
    F.MISC = (volatile LAS unsigned*)(F.lds + MISC_OFF);
    F.tid = threadIdx.x; F.lane = F.tid & 63; F.wave = __builtin_amdgcn_readfirstlane(F.tid >> 6);
    F.G = gridDim.x; { const int bx = blockIdx.x; F.vcu = (F.G % 8 == 0) ? (bx % 8) * (F.G / 8) + bx / 8 : bx; }
    unsigned char* ws = args.ws;
    F.ctl = (gu32*)(ws + WS_CTL);
    for (int u = F.tid; u < (LDS_BYTES - LDSCTL_OFF) / 4; u += NWAVES * 64) ((LAS unsigned*)(F.lds + LDSCTL_OFF))[u] = 0u;
    __syncthreads();
    const int lo = args.ph_lo, hi = args.ph_hi;
#ifdef PROBE_PHASE
#ifndef PROBE_BLK
#define PROBE_BLK 0
#endif
#define STAMP(k) do { if (blockIdx.x == PROBE_BLK && F.tid == 0) ((volatile LAS unsigned long long*)(F.lds + MISC_OFF + 128))[(k)] = __builtin_amdgcn_s_memrealtime(); } while (0)
    STAMP(0);
#else
#define STAMP(k) do { } while (0)
#endif
    XcdBarrier bar; bar.bar = (unsigned*)(F.ctl + CW_BAR); bar.x = 0; bar.st = nullptr;
    if (hi - lo > 1) bar = xcd_barrier_post((unsigned*)(F.ctl + CW_BAR), F.MISC + 8);
#define IN(k) (lo <= (k) && (k) < hi)
#define BOTH(k) (IN(k) && IN((k) + 1))
    if (IN(0)) {
#ifndef NO_PRO
 for (int rep_ = 0; rep_ < REP_PRO; ++rep_) p0_prologue(F, args);
#endif
 if (BOTH(0)) xcd_barrier(bar); STAMP(1); }
    for (int l = 0; l < DEPTH; ++l) {
        const int pb = 1 + 3 * l;
        if (IN(pb)) {
#ifndef NO_IN
            pg8::Gemm g{(const bf16*)(ws + WS_XB), (const bf16*)(ws + WS_WIN) + (size_t)l * D_IN * D_MODEL, M_TOK, D_IN, D_MODEL};
            pg8::StaticOrder S; S.init(M_TOK, D_IN, F.G, (int)blockIdx.x);
            pg8::EpiIn E{(bf16*)(ws + WS_PROJ), (const float*)(ws + WS_SSQP), (unsigned*)(F.ctl + CW_NRM) + l * 64, (bf16*)(ws + WS_KT), (bf16*)(ws + WS_VT)};
            for (int rep_ = 0; rep_ < REP_IN; ++rep_)
            pg8::gemm_phase<pg8::EpiIn, pg8::StaticOrder, true, true>(F.lds + RING_OFF, g, S, E);
#endif
            if (l == 0) { if (F.G == 256) { if (blockIdx.x >= 128) late_convert(F, args, (int)blockIdx.x - 128, 128); } else late_convert(F, args, (int)blockIdx.x, F.G); }
            if (BOTH(pb)) xcd_barrier(bar);
            STAMP(pb + 1);
        }
        if (IN(pb + 1)) {
            for (int rep_ = 0; rep_ < REP_MIX; ++rep_) { MIXERS_PHASE(l); }
            if (BOTH(pb + 1)) xcd_barrier(bar);
            STAMP(pb + 2);
        }
        if (IN(pb + 2)) {
#ifndef NO_OUT
            pg8::Gemm g{(const bf16*)(ws + WS_Y), (const bf16*)(ws + WS_WOUT) + (size_t)l * D_MODEL * D_MIX, M_TOK, D_MODEL, D_MIX};
            pg8::StaticOrder S; S.init(M_TOK, D_MODEL, F.G, (int)blockIdx.x);
            if (l == 0) { pg8::EpiOut E{args.in[I_X], nullptr, (bf16*)(ws + WS_XB), (float*)(ws + WS_SSQP)};
                for (int rep_ = 0; rep_ < REP_OUT0; ++rep_)
                pg8::gemm_phase<pg8::EpiOut, pg8::StaticOrder, false, true>(F.lds + RING_OFF, g, S, E); }
            else { pg8::EpiOutFinal E{(const bf16*)(ws + WS_XB), args.out, args.in[I_NORMF], (float*)(ws + WS_XCHG), (unsigned*)(F.ctl + CW_PANEL)};
                pg8::gemm_phase<pg8::EpiOutFinal, pg8::StaticOrder, false, true>(F.lds + RING_OFF, g, S, E); }
#endif
            if (BOTH(pb + 2) && l == 0) xcd_barrier(bar);
            STAMP(pb + 3);
        }
    }
#ifdef PROBE_PHASE
#ifndef PROBE_A
#define PROBE_A PROBE_PHASE
#define PROBE_B (PROBE_PHASE + 1)
#endif
    STAMP(8);
    if (blockIdx.x == PROBE_BLK && F.tid == 0) { const unsigned long long dt = ((volatile LAS unsigned long long*)(F.lds + MISC_OFF + 128))[PROBE_B] - ((volatile LAS unsigned long long*)(F.lds + MISC_OFF + 128))[PROBE_A];
        const unsigned long long t0_ = __builtin_amdgcn_s_memrealtime(); while (__builtin_amdgcn_s_memrealtime() - t0_ < (unsigned long long)PROBE_K * dt) __builtin_amdgcn_s_sleep(8); }
#endif
#undef IN
#undef BOTH
}

namespace naive {
__device__ __forceinline__ float sigmoidf_(float x) { return 1.f / (1.f + __expf(-x)); }
__device__ __forceinline__ float siluf_(float x) { return x / (1.f + __expf(-x)); }
__device__ __forceinline__ bf16 tobf(float f) { return (bf16)f2bf(f); }

__global__ void __launch_bounds__(256) k_prologue(Args a) {
    unsigned char* ws = a.ws;
    const size_t gid = (size_t)blockIdx.x * 256 + threadIdx.x, gsz = (size_t)gridDim.x * 256;
    for (int l = 0; l < DEPTH; ++l) {
        bf16* wt = (bf16*)(ws + WS_WIN) + (size_t)l * D_IN * D_MODEL; const float* w = a.in[I_WIN] + (size_t)l * D_MODEL * D_IN; const float* g = a.in[I_NORMG] + l * D_MODEL;
        for (size_t i = gid; i < (size_t)D_IN * D_MODEL; i += gsz) { const int np = (int)(i / D_MODEL), k = (int)(i % D_MODEL); wt[i] = tobf(w[(size_t)k * D_IN + win_colmap(np)] * g[k]); }
        bf16* wo = (bf16*)(ws + WS_WOUT) + (size_t)l * D_MODEL * D_MIX; const float* w2 = a.in[I_WOUT] + (size_t)l * D_MIX * D_MODEL;
        for (size_t i = gid; i < (size_t)D_MODEL * D_MIX; i += gsz) { const int n = (int)(i / D_MIX), k = (int)(i % D_MIX); float v = w2[(size_t)k * D_MODEL + n]; if (k >= 256 && k < 768) v *= a.in[I_SUBG][l * VD + (k & 127)] * (1.0f - (0.8f - 0.6f * __expf(-0.3f * (float)l))); wo[i] = tobf(v); }
    }
    bf16* wst = (bf16*)(ws + WS_WST); const float* w = a.in[I_WS];
    for (size_t i = gid; i < (size_t)DEPTH * NG * CHUNK * CHUNK; i += gsz) { const int s = (int)(i & 127), t = (int)((i >> 7) & 127); wst[i] = tobf(s <= t ? w[i] : 0.f); }
}
__global__ void __launch_bounds__(256) k_rowstats(const float* x, bf16* xb, float* ssqp) {
    const int m = (blockIdx.x * 256 + threadIdx.x) >> 6, lane = threadIdx.x & 63;
    float s = 0.f;
    for (int j = 0; j < 16; ++j) { const float v = x[(size_t)m * D_MODEL + lane + 64 * j]; s += v * v; xb[(size_t)m * D_MODEL + lane + 64 * j] = tobf(v); }
    s = wave_sum(s);
    if (lane < 4) ssqp[(size_t)lane * M_TOK + m] = lane == 0 ? s : 0.f;
}
template <int MODE>
__global__ void __launch_bounds__(256) k_gemm(const bf16* __restrict__ A, const bf16* __restrict__ Bt, int M, int N, int K, bf16* P, const float* ssqp, const float* base, float* out, bf16* KT, bf16* VT, bf16* GT) {
    __shared__ float As[16][68];
    __shared__ float Bs[16][68];
    const int tx = threadIdx.x & 15, ty = threadIdx.x >> 4;
    const int m0 = blockIdx.y * 64, n0 = blockIdx.x * 64;
    float acc[4][4];
#pragma unroll
    for (int i = 0; i < 4; ++i)
#pragma unroll
        for (int j = 0; j < 4; ++j) acc[i][j] = 0.f;
    for (int k0 = 0; k0 < K; k0 += 16) {
        { const int r = threadIdx.x >> 2, c = (threadIdx.x & 3) * 4;
          const ushort4 av = *(const ushort4*)(A + (size_t)(m0 + r) * K + k0 + c);
          As[c + 0][r] = bf2f(av.x); As[c + 1][r] = bf2f(av.y); As[c + 2][r] = bf2f(av.z); As[c + 3][r] = bf2f(av.w);
          const ushort4 bv = *(const ushort4*)(Bt + (size_t)(n0 + r) * K + k0 + c);
          Bs[c + 0][r] = bf2f(bv.x); Bs[c + 1][r] = bf2f(bv.y); Bs[c + 2][r] = bf2f(bv.z); Bs[c + 3][r] = bf2f(bv.w); }
        __syncthreads();
#pragma unroll
        for (int kk = 0; kk < 16; ++kk) {
            float a[4], b[4];
#pragma unroll
            for (int i = 0; i < 4; ++i) a[i] = As[kk][ty * 4 + i];
#pragma unroll
            for (int j = 0; j < 4; ++j) b[j] = Bs[kk][tx * 4 + j];
#pragma unroll
            for (int i = 0; i < 4; ++i)
#pragma unroll
                for (int j = 0; j < 4; ++j) acc[i][j] = fmaf(a[i], b[j], acc[i][j]);
        }
        __syncthreads();
    }
#pragma unroll
    for (int i = 0; i < 4; ++i) {
        const int m = m0 + ty * 4 + i;
        if (MODE == 0) {
            const float s = ssqp[m] + ssqp[M_TOK + m] + ssqp[2 * M_TOK + m] + ssqp[3 * M_TOK + m];
            const float r = rsqrtf(s * (1.f / D_MODEL) + EPS);
#pragma unroll
            for (int j = 0; j < 4; ++j) { const int sc_ = win_colmap(n0 + tx * 4 + j); const float v = acc[i][j] * r;
                if (sc_ < 256) P[(size_t)m * PPITCH + PC_Z + sc_] = tobf(v); else if (sc_ < 512) GT[(size_t)m * 1024 + (sc_ - 256)] = tobf(v);
                else if (sc_ < 1024) P[(size_t)m * PPITCH + PC_Q + (sc_ - 512)] = tobf(v * C2);
                else if (sc_ < 1536) KT[kt_off(m, sc_ - 1024)] = tobf(v);
                else if (sc_ < 2048) VT[vt_off(m, sc_ - 1536)] = tobf(v);
                else if (sc_ < 2560) P[(size_t)m * PPITCH + PC_U + (sc_ - 2048)] = tobf(v);
                else P[(size_t)m * PPITCH + PC_G + (sc_ - 2560)] = tobf(siluf_(v)); }
        } else {
#pragma unroll
            for (int j = 0; j < 4; ++j) { const size_t off = (size_t)m * N + n0 + tx * 4 + j; out[off] = (base ? base[off] : bf2f(GT[off])) + acc[i][j]; }
        }
    }
}
__global__ void __launch_bounds__(256) k_glu(bf16* P, const bf16* GT) {
    const int t = blockIdx.x, c = threadIdx.x;
    const float a = bf2f(P[(size_t)t * PPITCH + PC_Z + c]), g = bf2f(GT[(size_t)t * 1024 + c]);
    P[(size_t)t * PPITCH + PC_Z + c] = tobf(a * sigmoidf_(g));
}
__global__ void __launch_bounds__(256) k_conv(const bf16* __restrict__ P, const float* __restrict__ cw, const float* __restrict__ cb, const float* __restrict__ lg, const float* __restrict__ lb, bf16* __restrict__ Y) {
    __shared__ float red[8];
    const int t = blockIdx.x, c = threadIdx.x, tb = t & (SEQ - 1);
    float acc = cb[c];
    for (int j = 0; j < CONV_W; ++j) { const int d = j - (CONV_W - 1); if (tb + d >= 0) acc = fmaf(cw[j * D_CONV + c], bf2f(P[(size_t)(t + d) * PPITCH + PC_Z + c]), acc); }
    float s = wave_sum(acc);
    if ((c & 63) == 0) red[c >> 6] = s;
    __syncthreads();
    const float mean = (red[0] + red[1] + red[2] + red[3]) * (1.f / D_CONV);
    const float d = acc - mean;
    float q = wave_sum(d * d);
    if ((c & 63) == 0) red[4 + (c >> 6)] = q;
    __syncthreads();
    const float var = (red[4] + red[5] + red[6] + red[7]) * (1.f / D_CONV);
    const float yv = d * rsqrtf(var + EPS) * lg[c] + lb[c];
    Y[(size_t)t * D_MIX + c] = tobf(siluf_(yv) * bf2f(P[(size_t)t * PPITCH + PC_G + c]));
}
__global__ void __launch_bounds__(64) k_attn(const bf16* __restrict__ P, const bf16* __restrict__ KT, const bf16* __restrict__ VT, const float* __restrict__ lq1, const float* __restrict__ lk1, const float* __restrict__ lq2, const float* __restrict__ lk2, float lam_init, float* __restrict__ Dd) {
    const int q = blockIdx.x * 64 + threadIdx.x;
    const int b = blockIdx.y >> 5, h = (blockIdx.y >> 3) & 3, vp = blockIdx.y & 7;
    const float sl2 = exp2f(-8.f * (float)(h + 1) / (float)NH) * LOG2E;
    float s1 = 0.f, s2 = 0.f;
    for (int i = 0; i < QKD; ++i) { s1 += lq1[i] * lk1[i]; s2 += lq2[i] * lk2[i]; }
    const float lam = __expf(s1) - __expf(s2) + lam_init;
    const size_t rb = (size_t)b * SEQ;
    float q0[QKD], q1[QKD];
    const bf16* qp = P + (rb + q) * PPITCH + PC_Q + h * 128;
#pragma unroll
    for (int d = 0; d < QKD; ++d) { q0[d] = bf2f(qp[d]); q1[d] = bf2f(qp[64 + d]); }
    float o0[16], o1[16];
#pragma unroll
    for (int d = 0; d < 16; ++d) { o0[d] = 0.f; o1[d] = 0.f; }
    float m0 = -1e30f, l0 = 0.f, m1 = -1e30f, l1 = 0.f;
    const int kmax = blockIdx.x * 64 + 63;
    for (int k = 0; k <= kmax; ++k) {
        float a0 = 0.f, a1 = 0.f;
#pragma unroll
        for (int d = 0; d < QKD; ++d) { a0 = fmaf(q0[d], bf2f(KT[kt_off((int)rb + k, h * 128 + d)]), a0); a1 = fmaf(q1[d], bf2f(KT[kt_off((int)rb + k, h * 128 + 64 + d)]), a1); }
        const float bias = sl2 * (float)(k - q);
        a0 += bias; a1 += bias;
        if (k <= q) {
            const float n0 = fmaxf(m0, a0), n1 = fmaxf(m1, a1);
            const float f0 = exp2f(m0 - n0), p0 = exp2f(a0 - n0), f1 = exp2f(m1 - n1), p1 = exp2f(a1 - n1);
            l0 = l0 * f0 + p0; l1 = l1 * f1 + p1;
#pragma unroll
            for (int d = 0; d < 16; ++d) { const float v = bf2f(VT[vt_off((int)rb + k, h * 128 + vp * 16 + d)]); o0[d] = fmaf(o0[d], f0, p0 * v); o1[d] = fmaf(o1[d], f1, p1 * v); }
            m0 = n0; m1 = n1;
        }
    }
    const float i0 = 1.f / l0, i1 = lam / l1;
    float* op = Dd + (rb + q) * D_ATTN + h * 128 + vp * 16;
#pragma unroll
    for (int d = 0; d < 16; ++d) op[d] = o0[d] * i0 - o1[d] * i1;
}
__global__ void __launch_bounds__(512) k_attn_combine(const float* __restrict__ Dd, const bf16* __restrict__ P, const float* __restrict__ subg, float lam_init, bf16* __restrict__ Y) {
    __shared__ float red[8];
    const int t = blockIdx.x, c = threadIdx.x;
    const float o = Dd[(size_t)t * D_ATTN + c];
    const float ss = wave_sum(o * o);
    if ((c & 63) == 0) red[c >> 6] = ss;
    __syncthreads();
    const int h = c >> 7;
    const float ms = (red[2 * h] + red[2 * h + 1]) * (1.f / VD);
    const float yv = o * rsqrtf(ms + EPS);
    Y[(size_t)t * D_MIX + D_CONV + c] = tobf(yv * bf2f(P[(size_t)t * PPITCH + PC_G + D_CONV + c]));
}
__global__ void __launch_bounds__(256) k_sgu_ln(const bf16* __restrict__ P, const float* __restrict__ lg, const float* __restrict__ lb, float* __restrict__ VVLN) {
    __shared__ float red[8];
    const int t = blockIdx.x, c = threadIdx.x;
    const float v = bf2f(P[(size_t)t * PPITCH + PC_VV + c]);
    float s = wave_sum(v);
    if ((c & 63) == 0) red[c >> 6] = s;
    __syncthreads();
    const float mean = (red[0] + red[1] + red[2] + red[3]) * (1.f / D_SGU);
    const float d = v - mean;
    float q = wave_sum(d * d);
    if ((c & 63) == 0) red[4 + (c >> 6)] = q;
    __syncthreads();
    const float var = (red[4] + red[5] + red[6] + red[7]) * (1.f / D_SGU);
    VVLN[(size_t)t * D_SGU + c] = d * rsqrtf(var + EPS) * lg[c] + lb[c];
}
__global__ void __launch_bounds__(256) k_sgu_mix(const bf16* __restrict__ P, const float* __restrict__ VVLN, const float* __restrict__ ws_, const float* __restrict__ bs, bf16* __restrict__ Y) {
    const int t = blockIdx.x, c = threadIdx.x, g = c >> 6;
    const int tl = t & (CHUNK - 1), t0 = t - tl;
    float acc = bs[g * CHUNK + tl];
    for (int s = 0; s <= tl; ++s) acc = fmaf(ws_[((size_t)g * CHUNK + tl) * CHUNK + s], VVLN[(size_t)(t0 + s) * D_SGU + c], acc);
    const float u = bf2f(P[(size_t)t * PPITCH + PC_U + c]);
    Y[(size_t)t * D_MIX + D_CONV + D_ATTN + c] = tobf(u * acc * bf2f(P[(size_t)t * PPITCH + PC_G + D_CONV + D_ATTN + c]));
}
__global__ void __launch_bounds__(256) k_final(float* x, const float* __restrict__ g) {
    const int m = (blockIdx.x * 256 + threadIdx.x) >> 6, lane = threadIdx.x & 63;
    float v[16]; float s = 0.f;
#pragma unroll
    for (int j = 0; j < 16; ++j) { v[j] = x[(size_t)m * D_MODEL + lane + 64 * j]; s += v[j] * v[j]; }
    s = wave_sum(s);
    const float r = rsqrtf(s * (1.f / D_MODEL) + EPS);
#pragma unroll
    for (int j = 0; j < 16; ++j) x[(size_t)m * D_MODEL + lane + 64 * j] = v[j] * r * g[lane + 64 * j];
}
}

#ifndef FAST_MASK
#define FAST_MASK 0xFF
#endif
static void run_naive_phase(int p, const Args& a, hipStream_t stream, int parts = 7) {
    unsigned char* ws = a.ws;
    bf16* XB = (bf16*)(ws + WS_XB); bf16* P = (bf16*)(ws + WS_PROJ); bf16* Y = (bf16*)(ws + WS_Y); float* SSQP = (float*)(ws + WS_SSQP);
    float* Dd = (float*)(ws + WS_DBG_D); float* VVLN = (float*)(ws + WS_DBG_VV);
    if (p == 0) { naive::k_prologue<<<2048, 256, 0, stream>>>(a); naive::k_rowstats<<<M_TOK / 4, 256, 0, stream>>>(a.in[I_X], XB, SSQP); return; }
    if (p == 7) { if (!((FAST_MASK >> 6) & 1)) naive::k_final<<<M_TOK / 4, 256, 0, stream>>>(a.out, a.in[I_NORMF]); return; }
    const int l = (p - 1) / 3, k = (p - 1) % 3;
    const float lam_init = 0.8f - 0.6f * expf(-0.3f * (float)l);
    if (k == 0) {
        naive::k_gemm<0><<<dim3(D_IN / 64, M_TOK / 64), 256, 0, stream>>>(XB, (const bf16*)(ws + WS_WIN) + (size_t)l * D_IN * D_MODEL, M_TOK, D_IN, D_MODEL, P, SSQP, nullptr, nullptr, (bf16*)(ws + WS_KT), (bf16*)(ws + WS_VT), Y);
        naive::k_glu<<<M_TOK, 256, 0, stream>>>(P, Y);
    } else if (k == 1) {
        if (parts & 1) naive::k_conv<<<M_TOK, 256, 0, stream>>>(P, a.in[I_CONVW] + l * CONV_W * D_CONV, a.in[I_CONVB] + l * D_CONV, a.in[I_CLNG] + l * D_CONV, a.in[I_CLNB] + l * D_CONV, Y);
        if (parts & 2) { naive::k_attn<<<dim3(SEQ / 64, BATCH * NH * 8), 64, 0, stream>>>(P, (const bf16*)(ws + WS_KT), (const bf16*)(ws + WS_VT), a.in[I_LQ1] + l * QKD, a.in[I_LK1] + l * QKD, a.in[I_LQ2] + l * QKD, a.in[I_LK2] + l * QKD, lam_init, Dd);
            naive::k_attn_combine<<<M_TOK, 512, 0, stream>>>(Dd, P, a.in[I_SUBG] + l * VD, lam_init, Y); }
        if (parts & 4) { naive::k_sgu_ln<<<M_TOK, 256, 0, stream>>>(P, a.in[I_SLNG] + l * D_SGU, a.in[I_SLNB] + l * D_SGU, VVLN);
            naive::k_sgu_mix<<<M_TOK, 256, 0, stream>>>(P, VVLN, a.in[I_WS] + (size_t)l * NG * CHUNK * CHUNK, a.in[I_BS] + l * NG * CHUNK, Y); }
    } else {
        naive::k_gemm<1><<<dim3(D_MODEL / 64, M_TOK / 64), 256, 0, stream>>>(Y, (const bf16*)(ws + WS_WOUT) + (size_t)l * D_MODEL * D_MIX, M_TOK, D_MODEL, D_MIX, nullptr, nullptr, l == 0 ? a.in[I_X] : nullptr, a.out, nullptr, nullptr, l == 0 ? nullptr : XB);
        naive::k_rowstats<<<M_TOK / 4, 256, 0, stream>>>(a.out, XB, SSQP);
    }
}
extern "C" void kernel_launch(void* const* d_in, const int* in_sizes, int n_in, void* d_out, int out_size, void* d_ws, size_t ws_size, hipStream_t stream) {
    static int grid = 0;
    if (grid == 0) {
        if (n_in != 18 || out_size != M_TOK * D_MODEL) { fprintf(stderr, "kernel_launch: unexpected shapes (n_in %d, out %d); nothing launched\n", n_in, out_size); grid = -1; return; }
        int dev = 0, cus = 0, per_cu = 0;
        if (hipGetDevice(&dev) != hipSuccess || hipDeviceGetAttribute(&cus, hipDeviceAttributeMultiprocessorCount, dev) != hipSuccess) { grid = -1; return; }
        if (hipFuncSetAttribute((const void*)mk_fwd, hipFuncAttributeMaxDynamicSharedMemorySize, LDS_BYTES) != hipSuccess) { fprintf(stderr, "kernel_launch: hipFuncSetAttribute failed\n"); grid = -1; return; }
        if (hipOccupancyMaxActiveBlocksPerMultiprocessor(&per_cu, (const void*)mk_fwd, NWAVES * 64, LDS_BYTES) != hipSuccess || per_cu < 1) { fprintf(stderr, "kernel_launch: occupancy query reports %d blocks per CU\n", per_cu); }
        (void)hipGetLastError();
        grid = cus;
        if (grid != 256) fprintf(stderr, "kernel_launch: %d CUs; this kernel is built for 256\n", grid);
    }
    if (grid < 0) return;
    Args a{};
    for (int i = 0; i < 18; ++i) a.in[i] = (const float*)d_in[i];
    a.out = (float*)d_out; a.ws = (unsigned char*)d_ws; a.dry = 1;
    int p = 0;
    while (p < N_PHASES) {
        if ((FAST_MASK >> p) & 1) {
            int q = p;
#ifdef SINGLE_PHASE_LAUNCH
            q = p + 1;
#else
            while (q < N_PHASES && ((FAST_MASK >> q) & 1)) ++q;
#endif
            (void)hipMemsetAsync((char*)d_ws + WS_CTL, 0, CTL_ZERO_BYTES, stream);
            a.ph_lo = p; a.ph_hi = q;
            hipLaunchKernelGGL(mk_fwd, dim3(grid), dim3(NWAVES * 64), LDS_BYTES, stream, a);
#ifdef SINGLE_PHASE_LAUNCH
            if (p == 2 || p == 5) { const int parts = (MIX_CONV ? 0 : 1) | (MIX_ATTN ? 0 : 2) | (MIX_SGU ? 0 : 4); if (parts) run_naive_phase(p, a, stream, parts); }
#endif
            p = q;
        } else { run_naive_phase(p, a, stream); ++p; }
    }
}
```

```cpp
#define FAST_MASK 0xFF
#define A_OVH 4
#include <hip/hip_runtime.h>
#include <cstdio>
#include <cstdint>
#include <cmath>

constexpr int D_MODEL = 1024, BATCH = 2, SEQ = 8192, DEPTH = 2, M_TOK = BATCH * SEQ;
constexpr int D_CONV = 256, D_ATTN = 512, D_SGU = 256, D_MIX = 1024;
constexpr int NH = 4, VD = 128, QKD = 64, CONV_W = 31, NG = 4, GD = 64, CHUNK = 128;
constexpr int D_IN = 3584;
constexpr int PPITCH = 2304;
constexpr int PC_Z = 0, PC_Q = 256, PC_U = 768, PC_VV = 1024, PC_G = 1280;
__host__ __device__ __forceinline__ size_t kt_off(int row, int c) { const int b = row >> 13, t = (row & 8191) >> 6, r = row & 63, h = c >> 7, cc = c & 127; return ((((size_t)(b * 4 + h) * 128 + t) * 2 + (cc >> 6)) * 8 + ((cc & 63) >> 3)) * 512 + r * 8 + (cc & 7); }
__host__ __device__ __forceinline__ size_t vt_off(int row, int c) { const int b = row >> 13, t = (row & 8191) >> 6, r = row & 63, h = c >> 7, cc = c & 127; return (((size_t)(b * 4 + h) * 128 + t) * 4 + (cc >> 5)) * 2048 + r * 32 + (cc & 31); }
constexpr float EPS = 1e-6f;
constexpr float LOG2E = 1.4426950408889634f;
constexpr float C2 = 0.125f * LOG2E;

#ifndef TILE_ROLES
#define TILE_ROLES 0x7AD296CB183504ull
#endif
__host__ __device__ __forceinline__ int tile_role(int pt) { return (int)((TILE_ROLES >> (4 * pt)) & 15ull); }

namespace pg8 {
#define PG8_LAS __attribute__((address_space(3)))
typedef unsigned short bf16_t;
typedef short bf16x8 __attribute__((ext_vector_type(8)));
typedef float f32x4 __attribute__((ext_vector_type(4)));
typedef unsigned u32x4 __attribute__((ext_vector_type(4)));
constexpr int BM = 256, BK = 64, HALF = 128, HTB = HALF * BK * 2  , STAGE_BYTES = 8 * HTB, NXCD = 8, WGM = 8;

__host__ __device__ __forceinline__ int lds_byte(int r, int c) { const int st = (r >> 4) * 2 + (c >> 5), rr = r & 15, cc = c & 31, ob = rr * 64 + cc * 2; return st * 1024 + (ob ^ (((ob >> 9) & 1) << 5)); }
__host__ __device__ __forceinline__ void stage_rc(int b, int& R, int& C) { const int st = b / 1024, sb = b % 1024, swz = sb ^ (((sb >> 9) & 1) << 5); R = (st >> 1) * 16 + swz / 64; C = (st & 1) * 32 + (swz % 64) / 2; }
__host__ __device__ __forceinline__ int perm32(int rho) { const int n = rho >> 4, i = rho & 15; return 8 * (i >> 2) + 4 * n + (i & 3); }
struct Unit { int pm, pn; };
struct Gemm { const bf16_t* A; const bf16_t* Bt; int M, N, K; };

struct StaticOrder {
    int nM, nN, nwg, G, c;
    __host__ __device__ void init(int M, int N, int G_, int c_) { nM = M / BM; nN = N / BM; nwg = nM * nN; G = G_; c = c_; }
    __host__ __device__ bool next(int i, Unit& u) const {
        const long L = (long)i * G + c; if (L >= nwg) return false;
        int wgid = (int)L; { const int q = nwg / NXCD, r = nwg % NXCD, xcd = wgid % NXCD, off = wgid / NXCD; wgid = (xcd < r ? xcd * (q + 1) : r * (q + 1) + (xcd - r) * q) + off; }
        const int nig = WGM * nN, gid = wgid / nig, fm = gid * WGM, gsz = (nM - fm) < WGM ? (nM - fm) : WGM;
        u.pm = fm + ((wgid % nig) % gsz); u.pn = (wgid % nig) / gsz; return true;
    }
    __device__ __forceinline__ void a_ready(const Unit&) const {}
    __device__ __forceinline__ void done(const Unit&) const {}
};


__device__ __forceinline__ unsigned cvt_pk_bf16(float lo, float hi) { unsigned r; asm volatile("v_cvt_pk_bf16_f32 %0, %1, %2" : "=v"(r) : "v"(lo), "v"(hi)); return r; }
__device__ __forceinline__ float xsum16(float v) { auto r = __builtin_amdgcn_permlane16_swap(__float_as_uint(v), __float_as_uint(v), false, false); return __uint_as_float(r[0]) + __uint_as_float(r[1]); }
__device__ __forceinline__ float xsum32(float v) { auto r = __builtin_amdgcn_permlane32_swap(__float_as_uint(v), __float_as_uint(v), false, false); return __uint_as_float(r[0]) + __uint_as_float(r[1]); }
template <int CTRL> __device__ __forceinline__ float dppf(float x) { return __builtin_bit_cast(float, __builtin_amdgcn_update_dpp(0, __builtin_bit_cast(int, x), CTRL, 0xf, 0xf, true)); }
__device__ __forceinline__ float rowmax16(float x) { x = fmaxf(x, dppf<0x121>(x)); x = fmaxf(x, dppf<0x122>(x)); x = fmaxf(x, dppf<0x124>(x)); x = fmaxf(x, dppf<0x128>(x)); return x; }
__device__ __forceinline__ float fast_sigmoid(float x) { return __builtin_amdgcn_rcpf(1.f + __builtin_amdgcn_exp2f(-1.4426950408889634f * x)); }
struct EpiIn {
    static constexpr bool PERM = true, AFTER_DRAIN = false, PREFETCH = false;
    bf16_t* P; const float* ssqp; unsigned* nrm; bf16_t* KT; bf16_t* VT;
    __device__ __forceinline__ void operator()(const f32x4 (&acc)[2][2][4][2], const Unit& u, int wr, int wc, int fr, int fq) const {
        const int row0 = u.pm * BM + wr * 64 + fr;
        float rsv[2][4];
        { float p4[2][4][4];
#pragma unroll
          for (int ai = 0; ai < 2; ++ai)
#pragma unroll
              for (int m = 0; m < 4; ++m) { const int row_ = row0 + ai * HALF + m * 16;
#pragma unroll
                  for (int k = 0; k < 4; ++k) p4[ai][m][k] = ssqp[k * 16384 + row_]; }
#pragma unroll
          for (int ai = 0; ai < 2; ++ai)
#pragma unroll
              for (int m = 0; m < 4; ++m) rsv[ai][m] = __builtin_amdgcn_rsqf(((p4[ai][m][0] + p4[ai][m][1]) + (p4[ai][m][2] + p4[ai][m][3])) * (1.0f / 1024.0f) + 1e-6f); }
#define RS_OF(ai, m) rsv[ai][m]
        const int pn = tile_role(u.pn);
        if (pn < 2) {
            const int col0 = pn * 128 + wc * 32 + 8 * fq;
#pragma unroll
            for (int ai = 0; ai < 2; ++ai)
#pragma unroll
                for (int m = 0; m < 4; ++m) { const float r = RS_OF(ai, m);
                    const f32x4 a0 = acc[ai][0][m][0] * r, a1 = acc[ai][0][m][1] * r, g0 = acc[ai][1][m][0] * r, g1 = acc[ai][1][m][1] * r;
                    u32x4 w; w.x = cvt_pk_bf16(a0[0] * fast_sigmoid(g0[0]), a0[1] * fast_sigmoid(g0[1])); w.y = cvt_pk_bf16(a0[2] * fast_sigmoid(g0[2]), a0[3] * fast_sigmoid(g0[3]));
                    w.z = cvt_pk_bf16(a1[0] * fast_sigmoid(g1[0]), a1[1] * fast_sigmoid(g1[1])); w.w = cvt_pk_bf16(a1[2] * fast_sigmoid(g1[2]), a1[3] * fast_sigmoid(g1[3]));
                    *(u32x4*)(P + (size_t)(row0 + ai * HALF + m * 16) * 2304 + col0) = w; asm volatile("" ::: "memory"); }
        } else {
            const int cbase = (pn == 2) ? 768 : (pn == 3) ? 1024 : (pn == 4) ? 1280 : (pn == 5) ? (1280 + 768) : (pn < 8) ? (256 + (pn - 6) * 256) : (1280 + 256 + (pn - 12) * 256);
            const int col0 = cbase + wc * 32 + 8 * fq; const bool kv = (pn >= 8 && pn < 12);
            const float sc = (pn == 6 || pn == 7) ? 0.18033688011112042f : 1.0f;
            const bool act = (pn == 4 || pn == 5 || pn >= 12); const bool qk = (pn >= 6 && pn < 10);
            float nmx0 = 0.f, nmx1 = 0.f;
#pragma unroll
            for (int ai = 0; ai < 2; ++ai)
#pragma unroll
                for (int m = 0; m < 4; ++m) { const float r = RS_OF(ai, m) * sc; const int row_ = row0 + ai * HALF + m * 16; bf16_t* rowp = P + (size_t)row_ * 2304 + col0;
#pragma unroll
                    for (int bj = 0; bj < 2; ++bj) { f32x4 v0 = acc[ai][bj][m][0] * r, v1 = acc[ai][bj][m][1] * r;
                        if (qk) { float s2 = ((v0[0] * v0[0] + v0[1] * v0[1]) + (v0[2] * v0[2] + v0[3] * v0[3])) + ((v1[0] * v1[0] + v1[1] * v1[1]) + (v1[2] * v1[2] + v1[3] * v1[3]));
                            s2 = xsum16(s2); s2 = xsum32(s2); if (bj == 0) nmx0 = fmaxf(nmx0, s2); else nmx1 = fmaxf(nmx1, s2); }
                        if (act) {
#pragma unroll
                            for (int e = 0; e < 4; ++e) { v0[e] = v0[e] * fast_sigmoid(v0[e]); v1[e] = v1[e] * fast_sigmoid(v1[e]); } }
                        u32x4 w; w.x = cvt_pk_bf16(v0[0], v0[1]); w.y = cvt_pk_bf16(v0[2], v0[3]); w.z = cvt_pk_bf16(v1[0], v1[1]); w.w = cvt_pk_bf16(v1[2], v1[3]);
                        if (!kv) *(u32x4*)(rowp + bj * HALF) = w;
                        else { const int c_ = (pn & 1) * 256 + bj * HALF + wc * 32 + 8 * fq; if (pn < 10) *(u32x4*)(KT + kt_off(row_, c_)) = w; else *(u32x4*)(VT + vt_off(row_, c_)) = w; } }
                    asm volatile("" ::: "memory"); }
            if (qk) {
                nmx0 = rowmax16(nmx0); nmx1 = rowmax16(nmx1);
                if (fr == 0 && fq == 0) { unsigned* d = nrm + ((u.pm >> 5) * 2 + ((pn - 6) >> 1)) * 16 + (2 * (pn & 1)) * 4 + (wc >> 1) * 2 + (wc & 1);
                    atomicMax(d, __float_as_uint(nmx0)); atomicMax(d + 4, __float_as_uint(nmx1)); }
            }
        }
    }
};
struct EpiOut {
    static constexpr bool PERM = false, AFTER_DRAIN = true, PREFETCH = false;
    const float* base; float* out; bf16_t* xb; float* ssqp;
    __device__ __forceinline__ void fused(f32x4 (&acc)[2][2][4][2], const Unit& u, int wr, int wc, int fr, int fq, PG8_LAS unsigned char* lds, int wid, int lane) const {
        typedef unsigned u32x2v __attribute__((ext_vector_type(2)));
        PG8_LAS float* Pq = (PG8_LAS float*)lds;
        const int col0 = u.pn * BM + wc * 32 + 4 * fq;
#pragma unroll
        for (int ai = 0; ai < 2; ++ai)
#pragma unroll
            for (int m = 0; m < 4; ++m) { const int r = ai * HALF + wr * 64 + m * 16 + fr; const size_t off = (size_t)(u.pm * BM + r) * 1024 + col0; float s = 0.f;
#pragma unroll
                for (int bj = 0; bj < 2; ++bj)
#pragma unroll
                    for (int n = 0; n < 2; ++n) { f32x4 bs;
                        if (base) bs = __builtin_nontemporal_load((const f32x4*)(base + off + bj * HALF + n * 16));
                        else { const u32x2v b = *(const u32x2v*)(xb + off + bj * HALF + n * 16); bs[0] = __uint_as_float(b.x << 16); bs[1] = __uint_as_float(b.x & 0xffff0000u); bs[2] = __uint_as_float(b.y << 16); bs[3] = __uint_as_float(b.y & 0xffff0000u); }
                        const f32x4 o = bs + acc[ai][bj][m][n];
                        if (out) *(f32x4*)(out + off + bj * HALF + n * 16) = o; s += (o[0] * o[0] + o[1] * o[1]) + (o[2] * o[2] + o[3] * o[3]);
                        u32x2v w; w.x = cvt_pk_bf16(o[0], o[1]); w.y = cvt_pk_bf16(o[2], o[3]); *(u32x2v*)(xb + off + bj * HALF + n * 16) = w; }
                s = xsum16(s); s = xsum32(s);
                if (fq == 0) Pq[r * 4 + wc] = s;
                if (m == 3) asm volatile("" ::: "memory"); }
        asm volatile("s_waitcnt lgkmcnt(0)" ::: "memory"); __builtin_amdgcn_s_barrier(); asm volatile("" ::: "memory");
        const int t = wid * 64 + lane;
        if (t < 256) ssqp[(size_t)u.pn * 16384 + u.pm * BM + t] = (Pq[t * 4 + 0] + Pq[t * 4 + 1]) + (Pq[t * 4 + 2] + Pq[t * 4 + 3]);
        asm volatile("s_waitcnt lgkmcnt(0)" ::: "memory"); __builtin_amdgcn_s_barrier(); asm volatile("" ::: "memory");
    }
};

struct EpiOutFinal {
    static constexpr bool PERM = false, AFTER_DRAIN = true, PREFETCH = false;
    __device__ __forceinline__ void prefetch(const Unit& u, int t, unsigned& d0, unsigned& d1) const {
        const bf16_t* p = xb + (size_t)(u.pm * BM + (t >> 2)) * 1024 + u.pn * BM + (t & 3) * 64;
        d0 = *(const volatile unsigned*)p; d1 = *(const volatile unsigned*)(p + (size_t)128 * 1024); }
    const bf16_t* xb; float* out; const float* gain; float* xbuf; unsigned* cnt;
    __device__ __forceinline__ void fused(f32x4 (&acc)[2][2][4][2], const Unit& u, int wr, int wc, int fr, int fq, PG8_LAS unsigned char* lds, int wid, int lane) const {
        typedef unsigned u32x2v __attribute__((ext_vector_type(2)));
        PG8_LAS float* Pq = (PG8_LAS float*)lds;
        PG8_LAS float* S = (PG8_LAS float*)(lds + 4096);
        const int col0 = u.pn * BM + wc * 32 + 4 * fq;
        constexpr int BPITCH = 528, BOFF = 8192;
        { const int t_ = wid * 64 + lane; u32x4 stg[16];
#pragma unroll
          for (int k = 0; k < 16; ++k) { const int idx = t_ + 512 * k; stg[k] = __builtin_nontemporal_load((const u32x4*)(xb + (size_t)(u.pm * BM + (idx >> 5)) * 1024 + u.pn * BM + (idx & 31) * 8)); }
#pragma unroll
          for (int k = 0; k < 16; ++k) { const int idx = t_ + 512 * k; *(PG8_LAS u32x4*)(lds + BOFF + (idx >> 5) * BPITCH + (idx & 31) * 16) = stg[k]; } }
        asm volatile("s_waitcnt lgkmcnt(0)" ::: "memory"); __builtin_amdgcn_s_barrier(); asm volatile("" ::: "memory");
#pragma unroll
        for (int ai = 0; ai < 2; ++ai)
#pragma unroll
            for (int m = 0; m < 4; ++m) { const int r = ai * HALF + wr * 64 + m * 16 + fr; float s = 0.f;
#pragma unroll
                for (int bj = 0; bj < 2; ++bj)
#pragma unroll
                    for (int n = 0; n < 2; ++n) { const u32x2v b = *(const PG8_LAS u32x2v*)(lds + BOFF + r * BPITCH + (wc * 32 + 4 * fq + bj * HALF + n * 16) * 2);
                        f32x4 o = acc[ai][bj][m][n]; o[0] += __uint_as_float(b.x << 16); o[1] += __uint_as_float(b.x & 0xffff0000u); o[2] += __uint_as_float(b.y << 16); o[3] += __uint_as_float(b.y & 0xffff0000u);
                        acc[ai][bj][m][n] = o; s += (o[0] * o[0] + o[1] * o[1]) + (o[2] * o[2] + o[3] * o[3]); }
                s = xsum16(s); s = xsum32(s);
                if (fq == 0) Pq[r * 4 + wc] = s;
                }
        asm volatile("s_waitcnt lgkmcnt(0)" ::: "memory"); __builtin_amdgcn_s_barrier(); asm volatile("" ::: "memory");
        const int t = wid * 64 + lane;
        if (t < 256) __hip_atomic_store(xbuf + (size_t)(u.pm * BM + t) * 4 + u.pn, (Pq[t * 4 + 0] + Pq[t * 4 + 1]) + (Pq[t * 4 + 2] + Pq[t * 4 + 3]), __ATOMIC_RELAXED, __HIP_MEMORY_SCOPE_AGENT);
        asm volatile("s_waitcnt vmcnt(0)" ::: "memory");
        if (wid < 4 && lane == 0) __hip_atomic_fetch_add(cnt + 16 * u.pm, 1u, __ATOMIC_RELAXED, __HIP_MEMORY_SCOPE_AGENT);
        if (wid == 0) { unsigned spins = 0;
            while ((unsigned)__builtin_amdgcn_readfirstlane(__hip_atomic_load(cnt + 16 * u.pm, __ATOMIC_RELAXED, __HIP_MEMORY_SCOPE_AGENT)) < 16u) { __builtin_amdgcn_s_sleep(2); if (++spins > (1u << 22)) break; }
            __builtin_amdgcn_fence(__ATOMIC_ACQUIRE, "agent"); }
        asm volatile("s_waitcnt vmcnt(0) lgkmcnt(0)" ::: "memory"); __builtin_amdgcn_s_barrier(); asm volatile("" ::: "memory");
        if (t < 256) { const float* sl = xbuf + (size_t)(u.pm * BM + t) * 4; float q = 0.f;
#pragma unroll
            for (int k = 0; k < 4; ++k) q += __hip_atomic_load(sl + k, __ATOMIC_RELAXED, __HIP_MEMORY_SCOPE_AGENT);
            S[t] = __builtin_amdgcn_rsqf(q * (1.0f / 1024.0f) + 1e-6f); }
        asm volatile("s_waitcnt lgkmcnt(0)" ::: "memory"); __builtin_amdgcn_s_barrier(); asm volatile("" ::: "memory");
#pragma unroll
        for (int bj = 0; bj < 2; ++bj)
#pragma unroll
            for (int n = 0; n < 2; ++n) { const f32x4 gv = *(const f32x4*)(gain + col0 + bj * HALF + n * 16);
#pragma unroll
                for (int ai = 0; ai < 2; ++ai)
#pragma unroll
                    for (int m = 0; m < 4; ++m) { const int r = ai * HALF + wr * 64 + m * 16 + fr; const float rs = S[r];
                        __builtin_nontemporal_store(acc[ai][bj][m][n] * rs * gv, (f32x4*)(out + (size_t)(u.pm * BM + r) * 1024 + col0 + bj * HALF + n * 16)); } }
        asm volatile("s_waitcnt lgkmcnt(0)" ::: "memory"); __builtin_amdgcn_s_barrier(); asm volatile("" ::: "memory");
    }
};

struct EpiOutP {
    static constexpr bool PERM = true, AFTER_DRAIN = true, PREFETCH = false;
    bf16_t* xb; float* ssqp; unsigned* pcnt; unsigned char* wsb; bool wt;
    __device__ __forceinline__ void fused(f32x4 (&acc)[2][2][4][2], const Unit& u, int wr, int wc, int fr, int fq, PG8_LAS unsigned char* lds, int wid, int lane) const {
        PG8_LAS float* Pq = (PG8_LAS float*)lds;
        const __amdgpu_buffer_rsrc_t wrs = __builtin_amdgcn_make_buffer_rsrc((void*)wsb, 0, 0x10000000, 0x00020000);
        const int col0 = u.pn * BM + wc * 32 + 8 * fq;
        u32x4 bb[2][4][2];
#pragma unroll
        for (int ai = 0; ai < 2; ++ai)
#pragma unroll
            for (int m = 0; m < 4; ++m) { const int r = ai * HALF + wr * 64 + m * 16 + fr; const size_t off = (size_t)(u.pm * BM + r) * 1024 + col0;
#pragma unroll
                for (int bj = 0; bj < 2; ++bj) bb[ai][m][bj] = *(const u32x4*)(xb + off + bj * HALF); }
        asm volatile("s_waitcnt vmcnt(0)" ::: "memory");
#pragma unroll
        for (int ai = 0; ai < 2; ++ai)
#pragma unroll
            for (int m = 0; m < 4; ++m) { const int r = ai * HALF + wr * 64 + m * 16 + fr; const size_t off = (size_t)(u.pm * BM + r) * 1024 + col0; float s = 0.f;
#pragma unroll
                for (int bj = 0; bj < 2; ++bj) { const u32x4 b = bb[ai][m][bj];
                    f32x4 o0 = acc[ai][bj][m][0], o1 = acc[ai][bj][m][1];
                    o0[0] += __uint_as_float(b.x << 16); o0[1] += __uint_as_float(b.x & 0xffff0000u); o0[2] += __uint_as_float(b.y << 16); o0[3] += __uint_as_float(b.y & 0xffff0000u);
                    o1[0] += __uint_as_float(b.z << 16); o1[1] += __uint_as_float(b.z & 0xffff0000u); o1[2] += __uint_as_float(b.w << 16); o1[3] += __uint_as_float(b.w & 0xffff0000u);
                    s += ((o0[0] * o0[0] + o0[1] * o0[1]) + (o0[2] * o0[2] + o0[3] * o0[3])) + ((o1[0] * o1[0] + o1[1] * o1[1]) + (o1[2] * o1[2] + o1[3] * o1[3]));
                    u32x4 w; w.x = cvt_pk_bf16(o0[0], o0[1]); w.y = cvt_pk_bf16(o0[2], o0[3]); w.z = cvt_pk_bf16(o1[0], o1[1]); w.w = cvt_pk_bf16(o1[2], o1[3]);
                    if (wt) __builtin_amdgcn_raw_buffer_store_b128(w, wrs, (unsigned)((const unsigned char*)(xb + off + bj * HALF) - wsb), 0, 16);
                    else *(u32x4*)(xb + off + bj * HALF) = w; }
                s = xsum16(s); s = xsum32(s);
                if (fq == 0) Pq[r * 4 + wc] = s; }
        asm volatile("s_waitcnt lgkmcnt(0)" ::: "memory"); __builtin_amdgcn_s_barrier(); asm volatile("" ::: "memory");
        const int t = wid * 64 + lane;
        if (t < 256) __hip_atomic_store(ssqp + (size_t)u.pn * 16384 + u.pm * BM + t, (Pq[t * 4 + 0] + Pq[t * 4 + 1]) + (Pq[t * 4 + 2] + Pq[t * 4 + 3]), __ATOMIC_RELAXED, __HIP_MEMORY_SCOPE_AGENT);
        asm volatile("s_waitcnt vmcnt(0) lgkmcnt(0)" ::: "memory"); __builtin_amdgcn_s_barrier(); asm volatile("" ::: "memory");
        if (t == 0) __hip_atomic_fetch_add(pcnt + 16 * u.pm, 1u, __ATOMIC_RELAXED, __HIP_MEMORY_SCOPE_AGENT);
    }
};

template <class Epi, class Sched, bool ALIGN_EPI = false, bool SP2 = false>
__device__ __forceinline__ void gemm_phase(PG8_LAS unsigned char* lds, const Gemm g, const Sched& S, const Epi& E) {
    int tid_ = threadIdx.x; asm volatile("" : "+v"(tid_));
    const int tid = tid_, wid = __builtin_amdgcn_readfirstlane(tid >> 6), lane = tid & 63, wr = wid >> 2, wc = wid & 3, fr = lane & 15, fq = lane >> 4;
    const int K = g.K, nt = K / BK;
    unsigned voffA[2], voffB[2];
#pragma unroll
    for (int i = 0; i < 2; ++i) { int R, C; stage_rc(tid * 16 + i * 8192, R, C); const int Rb = Epi::PERM ? ((R & ~31) + perm32(R & 31)) : R;
        voffA[i] = (unsigned)(R * K + C) * 2u; voffB[i] = (unsigned)(Rb * K + C) * 2u; }
    const size_t kstep = (size_t)(BK * 2);
    const size_t hstep = (size_t)HALF * K * 2;
    const size_t tstep = 2 * hstep;
    const unsigned ldsw = (unsigned)wid * 1024u;
    const int aoff = lds_byte(wr * 64 + fr, fq * 8), boff = lds_byte(wc * 32 + fr, fq * 8);
#define PG8_SA(b, h) (((b) * 2 + (h)) * HTB)
#define PG8_SB(b, h) ((4 + (b) * 2 + (h)) * HTB)
    const __amdgpu_buffer_rsrc_t rsrc_voffA = __builtin_amdgcn_make_buffer_rsrc((void*)g.A, 0, g.M * K * 2, 0x00020000), rsrc_voffB = __builtin_amdgcn_make_buffer_rsrc((void*)g.Bt, 0, g.N * K * 2, 0x00020000);
    const char* const base_voffA = (const char*)g.A; const char* const base_voffB = (const char*)g.Bt;
#define PG8_STAGE(bufoff, gbase, voff) do { const unsigned so_ = (unsigned)((const char*)(gbase) - base_##voff); _Pragma("unroll") for (int _i = 0; _i < 2; ++_i) \
        __builtin_amdgcn_raw_ptr_buffer_load_lds(rsrc_##voff, (PG8_LAS void*)(lds + (bufoff) + ldsw + _i * 8192), 16, (voff)[_i], so_, 0, 0); } while (0)
#define PG8_LDA(dst, b, h) do { _Pragma("unroll") for (int m = 0; m < 4; ++m) _Pragma("unroll") for (int k = 0; k < 2; ++k) dst[m][k] = *(const PG8_LAS bf16x8*)(lds + PG8_SA(b, h) + aoff + m * 2048 + k * 1024); } while (0)
#define PG8_LDB(dst, b, h) do { _Pragma("unroll") for (int n = 0; n < 2; ++n) _Pragma("unroll") for (int k = 0; k < 2; ++k) dst[n][k] = *(const PG8_LAS bf16x8*)(lds + PG8_SB(b, h) + boff + n * 2048 + k * 1024); } while (0)
#define PG8_MMA(ai, bj, At, Bt) do { __builtin_amdgcn_s_setprio(1); _Pragma("unroll") for (int m = 0; m < 4; ++m) _Pragma("unroll") for (int n = 0; n < 2; ++n) _Pragma("unroll") for (int k = 0; k < 2; ++k) \
        acc[ai][bj][m][n] = __builtin_amdgcn_mfma_f32_16x16x32_bf16(Bt[n][k], At[m][k], acc[ai][bj][m][n], 0, 0, 0); __builtin_amdgcn_s_setprio(0); } while (0)
#define PG8_WAIT_V(n) asm volatile("s_waitcnt vmcnt(" #n ")" ::: "memory")
#define PG8_WAIT_L(n) asm volatile("s_waitcnt lgkmcnt(" #n ")" ::: "memory")
#define PG8_BAR __builtin_amdgcn_s_barrier()
#define PG8_SCHED __builtin_amdgcn_sched_barrier(0)
    Unit cur, nxt; int ui = 0;
    if (!S.next(0, cur)) return;
    f32x4 acc[2][2][4][2];
#pragma unroll
    for (int a = 0; a < 2; ++a)
#pragma unroll
        for (int b = 0; b < 2; ++b)
#pragma unroll
            for (int m = 0; m < 4; ++m)
#pragma unroll
                for (int n = 0; n < 2; ++n) acc[a][b][m][n] = (f32x4){0.f, 0.f, 0.f, 0.f};
    bf16x8 At[4][2], B0[2][2], B1[2][2];
    const char* cA = (const char*)g.A + (size_t)cur.pm * tstep; const char* cB = (const char*)g.Bt + (size_t)cur.pn * tstep;
    S.a_ready(cur);
    if constexpr (SP2) {
        PG8_STAGE(PG8_SB(0, 0), cB, voffB); PG8_STAGE(PG8_SB(0, 1), cB + hstep, voffB); PG8_STAGE(PG8_SA(0, 0), cA, voffA); PG8_STAGE(PG8_SA(0, 1), cA + hstep, voffA);
        if (wr == 1) PG8_BAR;
        PG8_WAIT_V(2); PG8_BAR;
        PG8_STAGE(PG8_SB(1, 0), cB + kstep, voffB); PG8_STAGE(PG8_SA(1, 0), cA + kstep, voffA); PG8_STAGE(PG8_SB(1, 1), cB + hstep + kstep, voffB);
        PG8_WAIT_V(6); PG8_BAR;
    } else {
        PG8_STAGE(PG8_SB(0, 0), cB, voffB); PG8_STAGE(PG8_SA(0, 0), cA, voffA); PG8_STAGE(PG8_SB(0, 1), cB + hstep, voffB); PG8_STAGE(PG8_SA(0, 1), cA + hstep, voffA);
        if (wr == 1) PG8_BAR;
        PG8_WAIT_V(4); PG8_BAR;
        PG8_STAGE(PG8_SB(1, 0), cB + kstep, voffB); PG8_STAGE(PG8_SA(1, 0), cA + kstep, voffA); PG8_STAGE(PG8_SB(1, 1), cB + hstep + kstep, voffB);
        PG8_WAIT_V(6); PG8_BAR;
    }
    unsigned pfd0 = 0u, pfd1 = 0u;
    for (;;) {
        const bool has_next = S.next(ui + 1, nxt);
        const char* nA = has_next ? (const char*)g.A + (size_t)nxt.pm * tstep : cA; const char* nB = has_next ? (const char*)g.Bt + (size_t)nxt.pn * tstep : cB;
        for (int t = 0; t < nt; t += 2) {
            const bool last = (t == nt - 2);
            const char* a1 = cA + (size_t)(t + 1) * kstep;
            const char* a2 = last ? nA : cA + (size_t)(t + 2) * kstep; const char* b2 = last ? nB : cB + (size_t)(t + 2) * kstep;
            const char* a3 = a2 + kstep; const char* b3 = b2 + kstep;
            if (last && has_next) S.a_ready(nxt);
            if constexpr (Epi::PREFETCH) { if (last && !has_next) E.prefetch(cur, wid * 64 + lane, pfd0, pfd1); }
            if constexpr (SP2) {
            PG8_LDB(B0, 0, 0); PG8_LDB(B1, 0, 1); PG8_SCHED; PG8_LDA(At, 0, 0); PG8_STAGE(PG8_SA(1, 1), a1 + hstep, voffA);
            PG8_WAIT_V(8); PG8_WAIT_L(0); PG8_BAR; PG8_MMA(0, 0, At, B0); PG8_MMA(0, 1, At, B1); PG8_BAR; PG8_SCHED;
            PG8_LDA(At, 0, 1); PG8_STAGE(PG8_SB(0, 0), b2, voffB); PG8_STAGE(PG8_SB(0, 1), b2 + hstep, voffB); PG8_STAGE(PG8_SA(0, 0), a2, voffA);
            PG8_WAIT_V(8); PG8_WAIT_L(0); PG8_BAR; PG8_MMA(1, 0, At, B0); PG8_MMA(1, 1, At, B1); PG8_BAR; PG8_SCHED;
            PG8_LDB(B0, 1, 0); PG8_LDB(B1, 1, 1); PG8_SCHED; PG8_LDA(At, 1, 0); PG8_STAGE(PG8_SA(0, 1), a2 + hstep, voffA);
            PG8_WAIT_V(8); PG8_WAIT_L(0); PG8_BAR; PG8_MMA(0, 0, At, B0); PG8_MMA(0, 1, At, B1); PG8_BAR; PG8_SCHED;
            PG8_LDA(At, 1, 1); PG8_STAGE(PG8_SB(1, 0), b3, voffB); PG8_STAGE(PG8_SB(1, 1), b3 + hstep, voffB); PG8_STAGE(PG8_SA(1, 0), a3, voffA);
            PG8_WAIT_V(8); PG8_WAIT_L(0); PG8_BAR; PG8_MMA(1, 0, At, B0); PG8_MMA(1, 1, At, B1); PG8_BAR; PG8_SCHED;
            } else {
            PG8_LDB(B0, 0, 0); PG8_SCHED; PG8_LDA(At, 0, 0); PG8_STAGE(PG8_SA(1, 1), a1 + hstep, voffA);
            PG8_WAIT_L(8); PG8_BAR; PG8_WAIT_L(0); PG8_MMA(0, 0, At, B0); PG8_BAR; PG8_SCHED;
            PG8_LDB(B1, 0, 1); PG8_STAGE(PG8_SB(0, 0), b2, voffB);
            PG8_BAR; PG8_WAIT_L(0); PG8_MMA(0, 1, At, B1); PG8_BAR;
            PG8_LDA(At, 0, 1); PG8_STAGE(PG8_SA(0, 0), a2, voffA);
            PG8_BAR; PG8_WAIT_L(0); PG8_MMA(1, 0, At, B0); PG8_BAR; PG8_SCHED;
            PG8_STAGE(PG8_SB(0, 1), b2 + hstep, voffB);
            PG8_WAIT_V(6); PG8_BAR; PG8_MMA(1, 1, At, B1); PG8_BAR;
            PG8_LDB(B0, 1, 0); PG8_SCHED; PG8_LDA(At, 1, 0); PG8_STAGE(PG8_SA(0, 1), a2 + hstep, voffA);
            PG8_WAIT_L(8); PG8_BAR; PG8_WAIT_L(0); PG8_MMA(0, 0, At, B0); PG8_BAR; PG8_SCHED;
            PG8_LDB(B1, 1, 1); PG8_STAGE(PG8_SB(1, 0), b3, voffB);
            PG8_BAR; PG8_WAIT_L(0); PG8_MMA(0, 1, At, B1); PG8_BAR;
            PG8_LDA(At, 1, 1); PG8_STAGE(PG8_SA(1, 0), a3, voffA);
            PG8_BAR; PG8_WAIT_L(0); PG8_MMA(1, 0, At, B0); PG8_BAR; PG8_SCHED;
            PG8_STAGE(PG8_SB(1, 1), b3 + hstep, voffB);
            PG8_WAIT_V(6); PG8_BAR; PG8_MMA(1, 1, At, B1); PG8_BAR;
            }
        }
        if constexpr (ALIGN_EPI) { if (wr == 0) PG8_BAR; }
        if constexpr (!Epi::AFTER_DRAIN) { E(acc, cur, wr, wc, fr, fq); S.done(cur); }
        if (!has_next) break;
#pragma unroll
        for (int a = 0; a < 2; ++a)
#pragma unroll
            for (int b = 0; b < 2; ++b)
#pragma unroll
                for (int m = 0; m < 4; ++m)
#pragma unroll
                    for (int n = 0; n < 2; ++n) acc[a][b][m][n] = (f32x4){0.f, 0.f, 0.f, 0.f};
        cur = nxt; cA = nA; cB = nB; ++ui;
        if constexpr (ALIGN_EPI) { if (wr == 1) PG8_BAR; }
    }
    PG8_WAIT_V(0);
    if constexpr (Epi::PREFETCH) { asm volatile("" :: "v"(pfd0), "v"(pfd1)); }
    if constexpr (!ALIGN_EPI) { if (wr == 0) PG8_BAR; }
    PG8_BAR;
    if constexpr (Epi::AFTER_DRAIN) { E.fused(acc, cur, wr, wc, fr, fq, lds, wid, lane); S.done(cur); }
#undef PG8_SA
#undef PG8_SB
#undef PG8_STAGE
#undef PG8_LDA
#undef PG8_LDB
#undef PG8_MMA
#undef PG8_WAIT_V
#undef PG8_WAIT_L
#undef PG8_BAR
#undef PG8_SCHED
}
}

#define GAS __attribute__((address_space(1)))
#define LAS __attribute__((address_space(3)))
typedef unsigned short bf16;
typedef unsigned v4u __attribute__((ext_vector_type(4)));
typedef float f32x4 __attribute__((ext_vector_type(4)));
typedef short bf16x8 __attribute__((ext_vector_type(8)));
typedef GAS unsigned gu32;
typedef GAS unsigned long long gu64;
#define RLX_AGENT __ATOMIC_RELAXED, __HIP_MEMORY_SCOPE_AGENT
#define LDS_WAIT() asm volatile("s_waitcnt lgkmcnt(0)" ::: "memory")
#define VM_WAIT() asm volatile("s_waitcnt vmcnt(0)" ::: "memory")
__device__ __forceinline__ unsigned long long rt() { return __builtin_amdgcn_s_memrealtime(); }
__device__ __forceinline__ unsigned f2bf(float f) { unsigned u = __builtin_bit_cast(unsigned, f); return (u + 0x7fffu + ((u >> 16) & 1u)) >> 16; }
__device__ __forceinline__ unsigned pk2(float lo, float hi) { return f2bf(lo) | (f2bf(hi) << 16); }

#define XB_TMO      128
#define XB_XCNT(j)  (256  + 64 * (j))
#define XB_XSUB(j)  (1280 + 64 * (j))
#define XB_XGEN(j)  (2304 + 64 * (j))
#define XB_TOP      3328
#define XB_TOPGEN   3392
#define XCD_BAR_WORDS 3456
#define XB_SPIN_CAP (1u << 18)

__device__ __forceinline__ unsigned xb_ld(unsigned* p)              { return __hip_atomic_load(p, __ATOMIC_RELAXED, __HIP_MEMORY_SCOPE_AGENT); }
__device__ __forceinline__ unsigned xb_add(unsigned* p, unsigned v) { return __hip_atomic_fetch_add(p, v, __ATOMIC_RELAXED, __HIP_MEMORY_SCOPE_AGENT); }
__device__ __forceinline__ unsigned xb_xcc_id() { return (unsigned)__builtin_amdgcn_s_getreg((3 << 11) | 20) & 0xFu; }
#define XB_SPIN(cond, bar) do { unsigned _sp = 0; while (cond) { __builtin_amdgcn_s_sleep(1); \
    if ((++_sp & 255u) == 0u) { if (xb_ld(&(bar)[XB_TMO])) break; if (_sp > XB_SPIN_CAP) { atomicAdd(&(bar)[XB_TMO], 1u); break; } } } } while (0)

struct XcdBarrier {
    unsigned* bar; unsigned x;
    volatile LAS unsigned* st;
};

__device__ __forceinline__ XcdBarrier xcd_barrier_post(unsigned* bar, volatile LAS unsigned* st) {
    XcdBarrier b; b.bar = bar; b.x = xb_xcc_id(); b.st = st;
    if (threadIdx.x == 0) (void)xb_add(&bar[XB_XCNT(b.x)], 1u);
    return b;
}
__device__ __forceinline__ void xcd_barrier_complete(unsigned* bar, unsigned x, unsigned& nloc, unsigned& nx) {
    const unsigned G = gridDim.x * gridDim.y * gridDim.z;
    unsigned sum, cnt, mine, sp = 0u;
    for (;;) {
        sum = 0u; cnt = 0u; mine = 0u;
#pragma unroll
        for (unsigned j = 0; j < 16; ++j) { const unsigned c = xb_ld(&bar[XB_XCNT(j)]); sum += c; cnt += (c > 0u) ? 1u : 0u; mine = (j == x) ? c : mine; }
        if (sum == G) break;
        __builtin_amdgcn_s_sleep(1);
        if ((++sp & 255u) == 0u) { if (xb_ld(&bar[XB_TMO])) break; if (sp > XB_SPIN_CAP) { atomicAdd(&bar[XB_TMO], 1u); break; } }
    }
    nloc = mine > 0u ? mine : 1u; nx = cnt > 0u ? cnt : 1u;
}

__device__ __forceinline__ void xcd_barrier(const XcdBarrier& b) {
    asm volatile("s_waitcnt vmcnt(0)" ::: "memory");
    __syncthreads();
    if (threadIdx.x == 0) {
        unsigned* bar = b.bar;
        __builtin_amdgcn_s_waitcnt(0);
        unsigned nloc = b.st[0], nx = b.st[1];
        if (nloc == 0u) { xcd_barrier_complete(bar, b.x, nloc, nx); b.st[0] = nloc; b.st[1] = nx; }
        const unsigned old = xb_add(&bar[XB_XSUB(b.x)], 1u);
        const unsigned gen = old / nloc;
        if (old + 1u == (gen + 1u) * nloc) {
            __builtin_amdgcn_fence(__ATOMIC_RELEASE, "agent");
            asm volatile("s_waitcnt vmcnt(0)" ::: "memory");
            const unsigned og = xb_add(&bar[XB_TOP], 1u);
            const unsigned tg = og / nx;
            if (og + 1u == (tg + 1u) * nx) xb_add(&bar[XB_TOPGEN], 1u);
            else XB_SPIN(xb_ld(&bar[XB_TOPGEN]) == tg, bar);
            __builtin_amdgcn_fence(__ATOMIC_ACQUIRE, "agent");
            xb_add(&bar[XB_XGEN(b.x)], 1u);
            asm volatile("s_waitcnt vmcnt(0)" ::: "memory");
        } else {
            XB_SPIN(xb_ld(&bar[XB_XGEN(b.x)]) == gen, bar);
            __builtin_amdgcn_fence(__ATOMIC_ACQUIRE, "agent");
            asm volatile("s_waitcnt vmcnt(0)" ::: "memory");
        }
    }
    __syncthreads();
}

namespace mix {
typedef short bf16x8 __attribute__((ext_vector_type(8)));
typedef short s16x4 __attribute__((ext_vector_type(4)));
typedef short v4i16_t __attribute__((ext_vector_type(4)));
typedef float f32x16 __attribute__((ext_vector_type(16)));
typedef float f32x4 __attribute__((ext_vector_type(4)));
typedef unsigned u32x4 __attribute__((ext_vector_type(4)));
typedef unsigned u32x2 __attribute__((ext_vector_type(2)));
typedef __attribute__((address_space(3))) const unsigned char* lds_cptr;
typedef __attribute__((address_space(3))) unsigned char* lds_ptr;
#define MIX_WAIT_BAR(N) asm volatile("s_waitcnt vmcnt(" #N ") lgkmcnt(0)\n\ts_barrier" ::: "memory")
#define MIX_LBAR() asm volatile("s_waitcnt lgkmcnt(0)\n\ts_barrier" ::: "memory")
#define MIX_VBAR(N) asm volatile("s_waitcnt vmcnt(" #N ")\n\ts_barrier" ::: "memory")
template <int CTRL> __device__ __forceinline__ float dpp_mov(float x) { return __builtin_bit_cast(float, __builtin_amdgcn_update_dpp(0, __builtin_bit_cast(int, x), CTRL, 0xf, 0xf, true)); }
__device__ __forceinline__ float wave_sum(float x) {
    x += dpp_mov<0x121>(x); x += dpp_mov<0x122>(x); x += dpp_mov<0x124>(x); x += dpp_mov<0x128>(x);
    { auto r = __builtin_amdgcn_permlane16_swap(__float_as_uint(x), __float_as_uint(x), false, false); x = __uint_as_float(r[0]) + __uint_as_float(r[1]); }
    { auto r = __builtin_amdgcn_permlane32_swap(__float_as_uint(x), __float_as_uint(x), false, false); x = __uint_as_float(r[0]) + __uint_as_float(r[1]); }
    return x;
}
__device__ __forceinline__ int crow(int r, int hi) { return (r & 3) + 8 * (r >> 2) + 4 * hi; }
__device__ __forceinline__ void glds16(const void* gsrc, unsigned lds_dst) { unsigned keep;
    asm volatile("s_mov_b32 %0, m0\n\ts_mov_b32 m0, %2\n\ts_nop 0\n\tglobal_load_lds_dwordx4 %1, off\n\ts_mov_b32 m0, %0" : "=&s"(keep) : "v"(gsrc), "s"(lds_dst) : "memory"); }
__device__ __forceinline__ void glds16x4(const void* g0, const void* g1, const void* g2, const void* g3, unsigned d0, unsigned d1, unsigned d2, unsigned d3) { unsigned keep;
    asm volatile("s_mov_b32 %0, m0\n\ts_mov_b32 m0, %5\n\ts_nop 0\n\tglobal_load_lds_dwordx4 %1, off\n\ts_mov_b32 m0, %6\n\ts_nop 0\n\tglobal_load_lds_dwordx4 %2, off\n\t"
                 "s_mov_b32 m0, %7\n\ts_nop 0\n\tglobal_load_lds_dwordx4 %3, off\n\ts_mov_b32 m0, %8\n\ts_nop 0\n\tglobal_load_lds_dwordx4 %4, off\n\ts_mov_b32 m0, %0"
                 : "=&s"(keep) : "v"(g0), "v"(g1), "v"(g2), "v"(g3), "s"(d0), "s"(d1), "s"(d2), "s"(d3) : "memory"); }
typedef int i32x4s __attribute__((ext_vector_type(4)));
__device__ __forceinline__ void bdma4(unsigned voff, i32x4s rk, unsigned sk0, unsigned sk1, i32x4s rv, unsigned sv0, unsigned sv1, unsigned d0, unsigned d1, unsigned d2, unsigned d3) { unsigned keep;
    asm volatile("s_mov_b32 %0, m0\n\ts_mov_b32 m0, %8\n\ts_nop 0\n\tbuffer_load_dwordx4 %1, %2, %3 offen lds\n\ts_mov_b32 m0, %9\n\ts_nop 0\n\tbuffer_load_dwordx4 %1, %2, %4 offen lds\n\t"
                 "s_mov_b32 m0, %10\n\ts_nop 0\n\tbuffer_load_dwordx4 %1, %5, %6 offen lds\n\ts_mov_b32 m0, %11\n\ts_nop 0\n\tbuffer_load_dwordx4 %1, %5, %7 offen lds\n\ts_mov_b32 m0, %0"
                 : "=&s"(keep) : "v"(voff), "s"(rk), "s"(sk0), "s"(sk1), "s"(rv), "s"(sv0), "s"(sv1), "s"(d0), "s"(d1), "s"(d2), "s"(d3) : "memory"); }
__device__ __forceinline__ unsigned cvtpk(float lo, float hi) { unsigned r; asm("v_cvt_pk_bf16_f32 %0, %1, %2" : "=v"(r) : "v"(lo), "v"(hi)); return r; }
__device__ __forceinline__ s16x4 vtr(lds_cptr p) { return __builtin_bit_cast(s16x4, __builtin_amdgcn_ds_read_tr16_b64_v4i16((__attribute__((address_space(3))) v4i16_t*)p)); }
__device__ __forceinline__ float xhalf_sum(float v) { auto rr = __builtin_amdgcn_permlane32_swap(__float_as_uint(v), __float_as_uint(v), false, false); return __uint_as_float(rr[0]) + __uint_as_float(rr[1]); }
__device__ __forceinline__ float xhalf_max(float v) { auto rr = __builtin_amdgcn_permlane32_swap(__float_as_uint(v), __float_as_uint(v), false, false); return fmaxf(__uint_as_float(rr[0]), __uint_as_float(rr[1])); }

constexpr int A_SLOT = 16384, A_NK = 4, A_NV = 4, A_LDS_K = 0, A_LDS_V = A_NK * A_SLOT, A_LDS_X = 0, A_LDS_CI = (A_NK + A_NV) * A_SLOT, A_LDS_Q = A_LDS_CI + 4096  ;
constexpr int PITCH = PPITCH;
constexpr float THR = 32.0f;
#ifndef SKEW
#define SKEW 1
#endif
#define SBAR() __builtin_amdgcn_sched_barrier(0)
#define PIN(x) asm volatile("" : "+v"(x))
#define MFMA32(a, b, c) __builtin_amdgcn_mfma_f32_32x32x16_bf16(a, b, c, 0, 0, 0)
#define MX3(a, b, c) __builtin_fmaxf(__builtin_fmaxf((a), (b)), (c))
#define EX2(v) ((VAR & 2) ? (v) * 0.5f : __builtin_amdgcn_exp2f(v))
__device__ __forceinline__ bf16x8 kld(lds_cptr p) { return *(const __attribute__((address_space(3))) bf16x8*)p; }
template <int VAR> __device__ __forceinline__ void attn_unit(int b, int h, int qb, int t_lo, int t_end, int pw_lo, int pw_hi, int myw, unsigned epoch, float* slabs, unsigned* flags, const bf16* __restrict__ P, const bf16* __restrict__ KT, const bf16* __restrict__ VT, bf16* __restrict__ Y, float lam, lds_ptr lds, int dry) {
    int tid_ = threadIdx.x; asm volatile("" : "+v"(tid_));
    const int tid = tid_, lane = tid & 63, r32 = lane & 31, hi = lane >> 5; const int wid = __builtin_amdgcn_readfirstlane(tid >> 6), qw = wid & 3, map = wid >> 2;
    const long rowbase = (long)b * SEQ; const int q0 = qb * 128, NT = 2 * (qb + 1), n = t_end - t_lo; const bool band = (t_end == NT);
    const float sl2 = exp2f(-2.0f * (float)(h + 1)) * LOG2E;
    const unsigned lds0 = (unsigned)(uintptr_t)lds;
    const bf16* ksrc = KT + ((size_t)(b * 4 + h) * 128 + t_lo) * 8192 + wid * 512 + lane * 8;
    const bf16* vsrc = VT + ((size_t)(b * 4 + h) * 128 + t_lo) * 8192 + wid * 512 + lane * 8;
    const unsigned kdst = lds0 + A_LDS_K + wid * 1024, vdst = lds0 + A_LDS_V + wid * 1024;
    i32x4s rsk, rsv;
    { const unsigned long long kb_ = (unsigned long long)(uintptr_t)(KT + (size_t)(b * 4 + h) * 128 * 8192), vb_ = (unsigned long long)(uintptr_t)(VT + (size_t)(b * 4 + h) * 128 * 8192);
      rsk = (i32x4s){__builtin_amdgcn_readfirstlane((int)(unsigned)kb_), __builtin_amdgcn_readfirstlane((int)(unsigned)((kb_ >> 32) & 0xffffull)), 128 * 16384, 0x00020000};
      rsv = (i32x4s){__builtin_amdgcn_readfirstlane((int)(unsigned)vb_), __builtin_amdgcn_readfirstlane((int)(unsigned)((vb_ >> 32) & 0xffffull)), 128 * 16384, 0x00020000}; }
    const unsigned dvoff = (unsigned)(wid * 1024 + lane * 16);
#define DMA_K(i, so) do { if (VAR & 1) break; const bf16* ks_ = ksrc + (long)(i) * 8192; glds16(ks_, (unsigned)__builtin_amdgcn_readfirstlane(kdst + (so))); glds16(ks_ + 4096, (unsigned)__builtin_amdgcn_readfirstlane(kdst + (so) + 8192)); } while (0)
#define DMA_V(i, so) do { if (VAR & 1) break; const bf16* vs_ = vsrc + (long)(i) * 8192; glds16(vs_, (unsigned)__builtin_amdgcn_readfirstlane(vdst + (so))); glds16(vs_ + 4096, (unsigned)__builtin_amdgcn_readfirstlane(vdst + (so) + 8192)); } while (0)
    bf16x8 qr[4];
    { const bf16* qp = P + (rowbase + q0 + qw * 32 + r32) * PITCH + PC_Q + h * 128 + map * 64 + hi * 8;
#pragma unroll
      for (int d0 = 0; d0 < 4; ++d0) qr[d0] = *reinterpret_cast<const bf16x8*>(qp + d0 * 16); }
    DMA_K(0, 0); DMA_V(0, 0); DMA_K(1, A_SLOT);
    if (n > 2) DMA_K(2, 2 * A_SLOT);
    { __attribute__((address_space(3))) f32x4* ci = (__attribute__((address_space(3))) f32x4*)(lds + A_LDS_CI);
#pragma unroll
      for (int k = 0; k < 4; ++k) ci[k * 64 + lane] = (f32x4){sl2 * (float)crow(4 * k, hi), sl2 * (float)crow(4 * k + 1, hi), sl2 * (float)crow(4 * k + 2, hi), sl2 * (float)crow(4 * k + 3, hi)}; }
    const lds_cptr cip = (lds_cptr)lds + A_LDS_CI + lane * 16;
#define CILD(X, k) do { if (VAR & 64) break; const f32x4 t_ = *(const __attribute__((address_space(3))) f32x4*)(cip + (k) * 1024); X[4 * (k)] = t_[0]; X[4 * (k) + 1] = t_[1]; X[4 * (k) + 2] = t_[2]; X[4 * (k) + 3] = t_[3]; } while (0)
    f32x16 ot[4];
#pragma unroll
    for (int d = 0; d < 4; ++d) ot[d] = f32x16{};
    float mhat = 0.f, l_reg = 0.f, fsc = 1.f; bool resc = false;
    const int qrel = qw * 32 + r32;
    const lds_cptr kp0 = (lds_cptr)lds + A_LDS_K + map * 8192 + hi * 1024 + r32 * 16;
    const lds_cptr vp0 = (lds_cptr)lds + A_LDS_V + ((lane >> 4) & 1) * 32 + (lane & 3) * 8 + (4 * hi + ((lane & 15) >> 2)) * 64;
#define KSL(t) ((((t) + 4) & 3) * A_SLOT)
#define KB0(i) (sl2 * (float)(64 * (t_lo + (i)) - q0))
#define CMASK(C0, C1, i) do { const int jb_ = (i) - (n - 2); if (band && jb_ >= 0) { const int kb_ = 64 * jb_ + 4 * hi; \
        _Pragma("unroll") for (int r = 0; r < 16; ++r) { const int kv_ = kb_ + (r & 3) + 8 * (r >> 2); if (kv_ > qrel) C0[r] = -INFINITY; if (kv_ + 32 > qrel) C1[r] = -INFINITY; } } } while (0)
#define ROWMAX(C0, C1, i, rm) do { float a_ = MX3(C0[0], C0[1], C0[2]), b_ = MX3(C1[0], C1[1], C1[2]); \
        _Pragma("unroll") for (int r = 3; r < 15; r += 2) { a_ = MX3(a_, C0[r], C0[r + 1]); b_ = MX3(b_, C1[r], C1[r + 1]); } \
        a_ = __builtin_fmaxf(a_, C0[15]); b_ = __builtin_fmaxf(b_, C1[15]); const float kb0_ = KB0(i); \
        rm = xhalf_max(__builtin_fmaxf(a_ + kb0_, b_ + (kb0_ + sl2 * 32.0f))); } while (0)
    f32x16 pA0, pA1, pB0, pB1; bf16x8 kf0, kf1, kf2, kf3; s16x4 vl0, vl1, vl2, vl3, vh0, vh1, vh2, vh3; u32x4 pw0, pw1, pw2, pw3;
    float off0, off1;
#ifdef ATT_PRIO
    if (wid >= 4) __builtin_amdgcn_s_setprio(ATT_PRIO);
#endif
    if (n > 2) MIX_WAIT_BAR(6); else MIX_WAIT_BAR(4);
#define PKW(X, B) cvtpk(X[B], X[(B) + 1])
#define VFR(k) (bf16x8){vl##k[0], vl##k[1], vl##k[2], vl##k[3], vh##k[0], vh##k[1], vh##k[2], vh##k[3]}
#define VRD(k, f) do { if (VAR & 8) break; vl##k = vtr(vq_ + (((f) & 3) * 4096 + ((f) >> 2) * 1024)); vh##k = vtr(vq_ + (((f) & 3) * 4096 + ((f) >> 2) * 1024 + 512)); } while (0)
#define GAPA(MF, RD, A0, A1, A2, A3, W0, W1, PW) do { MF; RD; sacc += A0; sacc += A1; sacc += A2; sacc += A3; PIN(sacc); W0; W1; PIN(PW); SBAR(); } while (0)
#define GAPB(MF, RD, CI, X, B, OFF) do { MF; RD; CI; X[B] = EX2(X[B] + OFF); X[(B) + 1] = EX2(X[(B) + 1] + OFF); PIN(X); SBAR(); } while (0)
#define KRD(G, k, fo) do { if ((G) && !(VAR & 16)) { kf##k = kld(kn_ + (fo)); } } while (0)
#define STEP_DMA(i, GK, GV) do { if (GK) DMA_K((i) + 3, KSL((i) + 3)); if (GV) DMA_V((i) + 1, KSL((i) + 1)); } while (0)
#define STEP_A(C0, C1, P0, P1, i) do { SBAR(); const lds_cptr kq_ = kp0 + KSL(i), vq_ = vp0 + KSL((i) - 1); \
    float sacc = P0[0] + P0[1]; \
    GAPA(C0 = MFMA32(kf0, qr[0], C0), if (!(VAR & 16)) kf0 = kld(kq_ + 4096), P0[2], P0[3], P0[4], P0[5],     pw0[0] = PKW(P0, 0),  pw0[1] = PKW(P0, 2),  pw0); \
    GAPA(C1 = MFMA32(kf1, qr[0], C1), if (!(VAR & 16)) kf1 = kld(kq_ + 4608), P0[6], P0[7], P0[8], P0[9],     pw0[2] = PKW(P0, 4),  pw0[3] = PKW(P0, 6),  pw0); \
    GAPA(C0 = MFMA32(kf2, qr[1], C0),    if (!(VAR & 16)) kf2 = kld(kq_ + 6144), P0[10], P0[11], P0[12], P0[13], pw1[0] = PKW(P0, 8),  pw1[1] = PKW(P0, 10), pw1); \
    GAPA(C1 = MFMA32(kf3, qr[1], C1),    if (!(VAR & 16)) kf3 = kld(kq_ + 6656), P0[14], P0[15], P1[0], P1[1],   pw1[2] = PKW(P0, 12), pw1[3] = PKW(P0, 14), pw1); \
    GAPA(C0 = MFMA32(kf0, qr[2], C0),    VRD(0, 0),             P1[2], P1[3], P1[4], P1[5],     pw2[0] = PKW(P1, 0),  pw2[1] = PKW(P1, 2),  pw2); \
    GAPA(C1 = MFMA32(kf1, qr[2], C1),    VRD(1, 1),             P1[6], P1[7], P1[8], P1[9],     pw2[2] = PKW(P1, 4),  pw2[3] = PKW(P1, 6),  pw2); \
    GAPA(C0 = MFMA32(kf2, qr[3], C0),    VRD(2, 2),             P1[10], P1[11], P1[12], P1[13], pw3[0] = PKW(P1, 8),  pw3[1] = PKW(P1, 10), pw3); \
    GAPA(C1 = MFMA32(kf3, qr[3], C1),    VRD(3, 3),             P1[14], P1[15], 0.f, 0.f,       pw3[2] = PKW(P1, 12), pw3[3] = PKW(P1, 14), pw3); \
    l_reg += sacc; \
    } while (0)
#define STEP_D(C0, C1, i, MASKED) do { \
    if (MASKED) CMASK(C0, C1, i); \
    { float rm_; ROWMAX(C0, C1, i, rm_); resc = false; \
      if (__builtin_expect(__any(rm_ > mhat + THR), 0)) { const float mn_ = __builtin_fmaxf(mhat, rm_); fsc = EX2(mhat - mn_); l_reg *= fsc; mhat = mn_; resc = true; } \
      const float kb0_ = KB0(i); off0 = kb0_ - mhat; off1 = off0 + sl2 * 32.0f; } \
    SBAR(); } while (0)
#define STEP_B(C0, C1, P0, P1, i, GL) do { SBAR(); const lds_cptr kn_ = kp0 + KSL((i) + 1), vq_ = vp0 + KSL((i) - 1); \
    GAPB(ot[0] = MFMA32(VFR(0), __builtin_bit_cast(bf16x8, pw0), ot[0]), VRD(0, 4), (void)0,  C0, 0, off0); \
    GAPB(ot[1] = MFMA32(VFR(1), __builtin_bit_cast(bf16x8, pw0), ot[1]), VRD(1, 5), (void)0,  C0, 2, off0); \
    GAPB(ot[2] = MFMA32(VFR(2), __builtin_bit_cast(bf16x8, pw0), ot[2]), VRD(2, 6), CILD(P0, 0),  C0, 4, off0); \
    GAPB(ot[3] = MFMA32(VFR(3), __builtin_bit_cast(bf16x8, pw0), ot[3]), VRD(3, 7), CILD(P0, 1),  C0, 6, off0); \
    GAPB(ot[0] = MFMA32(VFR(0), __builtin_bit_cast(bf16x8, pw1), ot[0]), VRD(0, 8), CILD(P0, 2),  C0, 8, off0); \
    GAPB(ot[1] = MFMA32(VFR(1), __builtin_bit_cast(bf16x8, pw1), ot[1]), VRD(1, 9), CILD(P0, 3),  C0, 10, off0); \
    GAPB(ot[2] = MFMA32(VFR(2), __builtin_bit_cast(bf16x8, pw1), ot[2]), VRD(2, 10), CILD(P1, 0), C0, 12, off0); \
    GAPB(ot[3] = MFMA32(VFR(3), __builtin_bit_cast(bf16x8, pw1), ot[3]), VRD(3, 11), CILD(P1, 1), C0, 14, off0); \
    GAPB(ot[0] = MFMA32(VFR(0), __builtin_bit_cast(bf16x8, pw2), ot[0]), VRD(0, 12), CILD(P1, 2), C1, 0, off1); \
    GAPB(ot[1] = MFMA32(VFR(1), __builtin_bit_cast(bf16x8, pw2), ot[1]), VRD(1, 13), CILD(P1, 3), C1, 2, off1); \
    GAPB(ot[2] = MFMA32(VFR(2), __builtin_bit_cast(bf16x8, pw2), ot[2]), VRD(2, 14), (void)0, C1, 4, off1); \
    GAPB(ot[3] = MFMA32(VFR(3), __builtin_bit_cast(bf16x8, pw2), ot[3]), VRD(3, 15), (void)0, C1, 6, off1); \
    GAPB(ot[0] = MFMA32(VFR(0), __builtin_bit_cast(bf16x8, pw3), ot[0]), KRD(GL, 0, 0), (void)0,    C1, 8, off1); \
    GAPB(ot[1] = MFMA32(VFR(1), __builtin_bit_cast(bf16x8, pw3), ot[1]), KRD(GL, 1, 512), (void)0,  C1, 10, off1); \
    GAPB(ot[2] = MFMA32(VFR(2), __builtin_bit_cast(bf16x8, pw3), ot[2]), KRD(GL, 2, 2048), (void)0, C1, 12, off1); \
    GAPB(ot[3] = MFMA32(VFR(3), __builtin_bit_cast(bf16x8, pw3), ot[3]), KRD(GL, 3, 2560), (void)0, C1, 14, off1); \
    } while (0)
#define STEP_B0(C0, C1) do { SBAR(); _Pragma("unroll") for (int r = 0; r < 16; ++r) { C0[r] = EX2(C0[r] + off0); C1[r] = EX2(C1[r] + off1); } \
    kf0 = kld(kp0 + KSL(1)); kf1 = kld(kp0 + KSL(1) + 512); kf2 = kld(kp0 + KSL(1) + 2048); kf3 = kld(kp0 + KSL(1) + 2560); SBAR(); } while (0)
#define SYNC(i, LAST) do { if (!(LAST)) { ENDW(i); STEP_DMA((i) + 1, ((i) + 4 < n), ((i) + 2 < n)); } } while (0)
#define IT(C0, C1, P0, P1, i, GL, MASKED, LAST) do { STEP_A(C0, C1, P0, P1, i); STEP_D(C0, C1, i, MASKED); if (skw) SYNC(i, LAST); STEP_B(C0, C1, P0, P1, i, GL); RESC(); if (!skw) SYNC(i, LAST); } while (0)
#define STEP_DMA4(i) do { const unsigned sk_ = (unsigned)__builtin_amdgcn_readfirstlane((t_lo + (i) + 3) * 16384), sv_ = (unsigned)__builtin_amdgcn_readfirstlane((t_lo + (i) + 1) * 16384); \
        bdma4(dvoff, rsk, sk_, sk_ + 8192u, rsv, sv_, sv_ + 8192u, (unsigned)__builtin_amdgcn_readfirstlane(kdst + KSL((i) + 3)), (unsigned)__builtin_amdgcn_readfirstlane(kdst + KSL((i) + 3) + 8192), \
              (unsigned)__builtin_amdgcn_readfirstlane(vdst + KSL((i) + 1)), (unsigned)__builtin_amdgcn_readfirstlane(vdst + KSL((i) + 1) + 8192)); } while (0)
#define ITS(C0, C1, P0, P1, i) do { STEP_A(C0, C1, P0, P1, i); STEP_D(C0, C1, i, false); if (skw) { MIX_VBAR(4); STEP_DMA4((i) + 1); } STEP_B(C0, C1, P0, P1, i, true); RESC(); if (!skw) { MIX_VBAR(4); STEP_DMA4((i) + 1); } } while (0)
#define RESC() do { if (resc) { _Pragma("unroll") for (int d_ = 0; d_ < 4; ++d_) _Pragma("unroll") for (int r = 0; r < 16; ++r) ot[d_][r] *= fsc; } } while (0)
#define ENDW(i) do { if ((i) + 3 < n) { MIX_WAIT_BAR(4); } else if ((i) + 2 < n) { MIX_WAIT_BAR(2); } else { MIX_WAIT_BAR(0); } } while (0)
    const bool skw = __builtin_amdgcn_readfirstlane((int)(SKEW && (map == 1))) != 0;
    STEP_DMA(0, (3 < n), true);
#pragma unroll
    for (int k = 0; k < 4; ++k) { CILD(pA0, k); CILD(pA1, k); CILD(pB0, k); CILD(pB1, k); }
    { const lds_cptr kb = kp0;
#pragma unroll
      for (int d0 = 0; d0 < 4; ++d0) { const bf16x8 k0 = kld(kb + d0 * 2048), k1 = kld(kb + d0 * 2048 + 512);
          pA0 = MFMA32(k0, qr[d0], pA0); pA1 = MFMA32(k1, qr[d0], pA1); } }
    CMASK(pA0, pA1, 0);
    { float rm; ROWMAX(pA0, pA1, 0, rm); mhat = rm; const float kb0_ = KB0(0); off0 = kb0_ - mhat; off1 = off0 + sl2 * 32.0f; }
    if (skw) SYNC(0, false);
#pragma unroll
    for (int r = 0; r < 16; ++r) { pA0[r] = EX2(pA0[r] + off0); pA1[r] = EX2(pA1[r] + off1); }
    if (!skw) SYNC(0, false);
    kf0 = kld(kp0 + KSL(1)); kf1 = kld(kp0 + KSL(1) + 512); kf2 = kld(kp0 + KSL(1) + 2048); kf3 = kld(kp0 + KSL(1) + 2560);
    int i = 1;
#undef KSL
#define KSL(t) ((((t) - ib + 4) & 3) * A_SLOT)
    { int ib = 0;
      for (; ib + 8 < n; ib += 4) { ITS(pB0, pB1, pA0, pA1, ib + 1); ITS(pA0, pA1, pB0, pB1, ib + 2); ITS(pB0, pB1, pA0, pA1, ib + 3); ITS(pA0, pA1, pB0, pB1, ib + 4); }
      i = ib + 1; }
#undef KSL
#define KSL(t) ((((t) + 4) & 3) * A_SLOT)
    for (; i + 5 < n; i += 2) { ITS(pB0, pB1, pA0, pA1, i); ITS(pA0, pA1, pB0, pB1, i + 1); }
    for (; i + 1 < n; i += 2) {
        IT(pB0, pB1, pA0, pA1, i, (i + 1 < n), true, false);
        IT(pA0, pA1, pB0, pB1, i + 1, (i + 2 < n), true, false);
    }
    IT(pB0, pB1, pA0, pA1, n - 1, false, true, true);
    { float sacc = pB0[0] + pB0[1];
#pragma unroll
      for (int r = 2; r < 16; ++r) sacc += pB0[r];
#pragma unroll
      for (int r = 0; r < 16; ++r) sacc += pB1[r];
      l_reg += sacc;
      pw0 = (u32x4){PKW(pB0, 0), PKW(pB0, 2), PKW(pB0, 4), PKW(pB0, 6)}; pw1 = (u32x4){PKW(pB0, 8), PKW(pB0, 10), PKW(pB0, 12), PKW(pB0, 14)};
      pw2 = (u32x4){PKW(pB1, 0), PKW(pB1, 2), PKW(pB1, 4), PKW(pB1, 6)}; pw3 = (u32x4){PKW(pB1, 8), PKW(pB1, 10), PKW(pB1, 12), PKW(pB1, 14)};
      const lds_cptr vb = vp0 + KSL(n - 1);
#pragma unroll
      for (int db = 0; db < 4; ++db) {
          { const s16x4 lo = vtr(vb + db * 4096), hh = vtr(vb + db * 4096 + 512); ot[db] = MFMA32(((bf16x8){lo[0], lo[1], lo[2], lo[3], hh[0], hh[1], hh[2], hh[3]}), __builtin_bit_cast(bf16x8, pw0), ot[db]); }
          { const s16x4 lo = vtr(vb + db * 4096 + 1024), hh = vtr(vb + db * 4096 + 1024 + 512); ot[db] = MFMA32(((bf16x8){lo[0], lo[1], lo[2], lo[3], hh[0], hh[1], hh[2], hh[3]}), __builtin_bit_cast(bf16x8, pw1), ot[db]); }
          { const s16x4 lo = vtr(vb + db * 4096 + 2048), hh = vtr(vb + db * 4096 + 2048 + 512); ot[db] = MFMA32(((bf16x8){lo[0], lo[1], lo[2], lo[3], hh[0], hh[1], hh[2], hh[3]}), __builtin_bit_cast(bf16x8, pw2), ot[db]); }
          { const s16x4 lo = vtr(vb + db * 4096 + 3072), hh = vtr(vb + db * 4096 + 3072 + 512); ot[db] = MFMA32(((bf16x8){lo[0], lo[1], lo[2], lo[3], hh[0], hh[1], hh[2], hh[3]}), __builtin_bit_cast(bf16x8, pw3), ot[db]); } } }
#ifdef ATT_PRIO
    __builtin_amdgcn_s_setprio(0);
#endif
    if (!band && dry) { MIX_WAIT_BAR(0); return; }
    const __amdgpu_buffer_rsrc_t srs = __builtin_amdgcn_make_buffer_rsrc((void*)slabs, 0, 256 * 8 * 9 * 1024, 0x00020000);
    if (!band) {
        const unsigned so = (unsigned)(((myw * 8 + wid) * 9 * 64 + lane) * 16);
#pragma unroll
        for (int d = 0; d < 4; ++d)
#pragma unroll
            for (int j = 0; j < 2; ++j) __builtin_amdgcn_raw_buffer_store_b128((u32x4){cvtpk(ot[d][8 * j], ot[d][8 * j + 1]), cvtpk(ot[d][8 * j + 2], ot[d][8 * j + 3]), cvtpk(ot[d][8 * j + 4], ot[d][8 * j + 5]), cvtpk(ot[d][8 * j + 6], ot[d][8 * j + 7])}, srs, so + (d * 2 + j) * 1024, 0, 16);
        __builtin_amdgcn_raw_buffer_store_b128(__builtin_bit_cast(u32x4, (f32x4){mhat, l_reg, 0.f, 0.f}), srs, so + 8 * 1024, 0, 16);
        MIX_WAIT_BAR(0);
        if (tid == 0) __hip_atomic_store(flags + myw * 16, epoch, __ATOMIC_RELAXED, __HIP_MEMORY_SCOPE_AGENT);
        return;
    }
    u32x4 gv[8];
    { const bf16* gp = P + (rowbase + q0 + qw * 32 + r32) * PITCH + PC_G + 256 + h * 128 + 8 * hi;
      if (map == 0 && dry == 0) {
#pragma unroll
          for (int j = 0; j < 8; ++j) gv[j] = *(const u32x4*)(gp + 16 * j); } }
    if (!dry) for (int pw = pw_lo; pw < pw_hi; ++pw) {
        { unsigned spins = 0;
            while ((unsigned)__builtin_amdgcn_readfirstlane((int)__hip_atomic_load(flags + pw * 16, __ATOMIC_RELAXED, __HIP_MEMORY_SCOPE_AGENT)) != epoch) { __builtin_amdgcn_s_sleep(2); if (++spins > (1u << 22)) break; } }
        const unsigned so = (unsigned)(((pw * 8 + wid) * 9 * 64 + lane) * 16);
        const f32x4 ml = __builtin_bit_cast(f32x4, __builtin_amdgcn_raw_buffer_load_b128(srs, so + 8 * 1024, 0, 16));
        u32x4 po[8];
#pragma unroll
        for (int k = 0; k < 8; ++k) po[k] = __builtin_amdgcn_raw_buffer_load_b128(srs, so + k * 1024, 0, 16);
        const float mn = fmaxf(mhat, ml[0]), f0 = EX2(mhat - mn), f1 = EX2(ml[0] - mn);
        l_reg = l_reg * f0 + ml[1] * f1; mhat = mn;
#pragma unroll
        for (int d = 0; d < 4; ++d)
#pragma unroll
            for (int j = 0; j < 2; ++j)
#pragma unroll
                for (int e = 0; e < 4; ++e) { const unsigned w = po[d * 2 + j][e];
                    ot[d][8 * j + 2 * e] = ot[d][8 * j + 2 * e] * f0 + __uint_as_float(w << 16) * f1; ot[d][8 * j + 2 * e + 1] = ot[d][8 * j + 2 * e + 1] * f0 + __uint_as_float(w & 0xffff0000u) * f1; }
    }
    l_reg = xhalf_sum(l_reg);
    MIX_LBAR();
    __attribute__((address_space(3))) f32x4* xw = (__attribute__((address_space(3))) f32x4*)(lds + A_LDS_X) + qw * 1024 + lane;
    if (map == 1) {
        const float sc = lam / l_reg;
#pragma unroll
        for (int d = 0; d < 4; ++d)
#pragma unroll
            for (int r = 0; r < 16; r += 4) xw[(d * 4 + (r >> 2)) * 64] = (f32x4){ot[d][r] * sc, ot[d][r + 1] * sc, ot[d][r + 2] * sc, ot[d][r + 3] * sc};
    }
    MIX_LBAR();
    if (map == 0 && dry == 0) {
        const float sc = 1.0f / l_reg; float ss = 0.f;
#pragma unroll
        for (int d = 0; d < 4; ++d)
#pragma unroll
            for (int r = 0; r < 16; r += 4) { const f32x4 x4 = xw[(d * 4 + (r >> 2)) * 64];
#pragma unroll
                for (int e = 0; e < 4; ++e) { const float o = ot[d][r + e] * sc - x4[e]; ot[d][r + e] = o; ss += o * o; } }
        ss = xhalf_sum(ss);
        const float rn = __builtin_amdgcn_rsqf(ss * (1.0f / 128.0f) + EPS);
        const long row = rowbase + q0 + qw * 32 + r32;
        bf16* yp = Y + row * 1024 + 256 + h * 128 + 8 * hi;
#pragma unroll
        for (int j = 0; j < 8; ++j) {
            const int d = j >> 1, rq = 2 * (j & 1);
            u32x4 gl = gv[j];
            { auto r0 = __builtin_amdgcn_permlane32_swap(gl.x, gl.z, false, false); gl.x = r0[0]; gl.z = r0[1];
              auto r1 = __builtin_amdgcn_permlane32_swap(gl.y, gl.w, false, false); gl.y = r1[0]; gl.w = r1[1]; }
            u32x4 w;
            { const float g0 = __uint_as_float(gl.x << 16), g1 = __uint_as_float(gl.x & 0xffff0000u), g2 = __uint_as_float(gl.y << 16), g3 = __uint_as_float(gl.y & 0xffff0000u);
              w.x = cvtpk(ot[d][rq * 4 + 0] * rn * g0, ot[d][rq * 4 + 1] * rn * g1); w.y = cvtpk(ot[d][rq * 4 + 2] * rn * g2, ot[d][rq * 4 + 3] * rn * g3); }
            { const float g0 = __uint_as_float(gl.z << 16), g1 = __uint_as_float(gl.z & 0xffff0000u), g2 = __uint_as_float(gl.w << 16), g3 = __uint_as_float(gl.w & 0xffff0000u);
              w.z = cvtpk(ot[d][rq * 4 + 4] * rn * g0, ot[d][rq * 4 + 5] * rn * g1); w.w = cvtpk(ot[d][rq * 4 + 6] * rn * g2, ot[d][rq * 4 + 7] * rn * g3); }
            { auto r0 = __builtin_amdgcn_permlane32_swap(w.x, w.z, false, false); w.x = r0[0]; w.z = r0[1];
              auto r1 = __builtin_amdgcn_permlane32_swap(w.y, w.w, false, false); w.y = r1[0]; w.w = r1[1]; }
            *(u32x4*)(yp + 16 * j) = w; }
    }
    MIX_LBAR();
#undef DMA_K
#undef CILD
#undef DMA_V
#undef KSL
#undef KB0
#undef CMASK
#undef ROWMAX
#undef PKW
#undef VFR
#undef VRD
#undef GAPA
#undef GAPB
#undef KRD
#undef STEP_DMA
#undef STEP_DMA4
#undef STEP_A
#undef STEP_D
#undef STEP_B
#undef STEP_B0
#undef IT
#undef ITS
#undef SYNC
#undef RESC
#undef ENDW
}

constexpr float SKIP_T = 40.0f;
#ifndef A_OVH
#define A_OVH 2
#endif
#ifndef A_W3
#define A_W3 9
#endif
#ifndef A_W2
#define A_W2 8
#endif
constexpr int A_LDS_SCH = 148 * 1024;
template <int VAR> __device__ __forceinline__ void attn_phase(int l, int w, const unsigned* nrm, float* slabs, unsigned* flags, const bf16* __restrict__ P, const bf16* __restrict__ KT, const bf16* __restrict__ VT, bf16* __restrict__ Y, float lam, lds_ptr lds, int dry) {
    int tid_ = threadIdx.x; asm volatile("" : "+v"(tid_));
    const int tid = tid_, lane = tid & 63; const int wid = __builtin_amdgcn_readfirstlane(tid >> 6);
    __attribute__((address_space(3))) int* costs = (__attribute__((address_space(3))) int*)(lds + A_LDS_SCH);
    __attribute__((address_space(3))) int* pres = costs + 512;
    __attribute__((address_space(3))) int* wsum = pres + 512;
    int cost;
    { const int u = tid, bh = u >> 6, qb = u & 63, b = bh >> 2, h = bh & 3;
      const unsigned* nq = nrm + (b * 2 + 0) * 16 + h * 4; const unsigned* nk = nrm + (b * 2 + 1) * 16 + h * 4;
      const float a0 = (__uint_as_float(nq[0]) + __uint_as_float(nq[1])) * (__uint_as_float(nk[0]) + __uint_as_float(nk[1]));
      const float a1 = (__uint_as_float(nq[2]) + __uint_as_float(nq[3])) * (__uint_as_float(nk[2]) + __uint_as_float(nk[3]));
      const float nqk = sqrtf(fmaxf(a0, a1)) * 1.01f;
      const float sl2 = exp2f(-2.0f * (float)(h + 1)) * LOG2E;
      const float D = (2.0f * nqk + SKIP_T) / sl2;
      const int NT = 2 * (qb + 1);
      const float lim = (float)(128 * qb) - D - 63.0f;
      int t_lo = (lim >= 0.f) ? ((int)floorf(lim * (1.0f / 64.0f)) + 1) : 0;
      t_lo &= ~1; if (t_lo > NT - 2) t_lo = NT - 2; if (t_lo < 0) t_lo = 0;
      if (VAR & 4) t_lo = 0;
      cost = (NT - t_lo) >> 1; }
    const int wgt = ((tid >> 6) & 3) == 3 ? A_W3 : ((tid >> 6) & 3) == 2 ? A_W2 : 8;
    const int vcost = cost * wgt + 8 * A_OVH;
    int incl = vcost;
#pragma unroll
    for (int o = 1; o < 64; o <<= 1) { const int v = __shfl_up(incl, o); if (lane >= o) incl += v; }
    if (lane == 63) wsum[wid] = incl;
    __syncthreads();
    int base = 0, total = 0;
#pragma unroll
    for (int k = 0; k < 8; ++k) { const int v = wsum[k]; if (k < wid) base += v; total += v; }
    const int pre = base + incl - vcost;
    costs[tid] = cost; pres[tid] = pre;
    const int lo = (int)(((long)w * total) >> 8), hi = (int)(((long)(w + 1) * total) >> 8);
    if (pre <= lo && lo < pre + vcost) wsum[8] = tid;
    if (pre < hi && hi <= pre + vcost) wsum[9] = tid;
    __syncthreads();
    const int u_first = wsum[8], u_last = wsum[9];
    const unsigned epoch = (unsigned)l + 1u;
    for (int u = u_last; u >= u_first; --u) {
        const int c = costs[u], p0 = pres[u], bh = u >> 6, qb = u & 63, NT = 2 * (qb + 1), t0 = NT - 2 * c;
        const int W = (bh & 3) == 3 ? A_W3 : (bh & 3) == 2 ? A_W2 : 8, L = c * W + 8 * A_OVH;
        const int vlo = (lo > p0 ? lo : p0) - p0, vhi = (hi < p0 + L ? hi : p0 + L) - p0;
        const int s_lo = vlo > 8 * A_OVH ? (vlo - 8 * A_OVH) / W : 0, s_hi = vhi > 8 * A_OVH ? (vhi - 8 * A_OVH) / W : 0;
        if (s_hi <= s_lo) continue;
        int pw_lo = w;
        if (s_hi == c && s_lo > 0) { while (pw_lo > 0 && (int)(((long)pw_lo * total) >> 8) >= p0 + 8 * A_OVH + W) --pw_lo; }
        attn_unit<VAR>(bh >> 2, bh & 3, qb, t0 + 2 * s_lo, t0 + 2 * s_hi, pw_lo, w, w, epoch, slabs, flags, P, KT, VT, Y, lam, lds, dry);
    }
    MIX_LBAR();
}
__device__ __forceinline__ void conv_unit(int unit, const bf16* __restrict__ P, const bf16* __restrict__ MB, bf16* __restrict__ Y, const float* __restrict__ cw, const float* __restrict__ cb, const float* __restrict__ lg, const float* __restrict__ lb, lds_ptr lds) {
    int tid_ = threadIdx.x; asm volatile("" : "+v"(tid_));
    const int tid = tid_, lane = tid & 63; const int wid = __builtin_amdgcn_readfirstlane(tid >> 6);
    const int t0 = unit * 64; const bool first = (t0 & (SEQ - 1)) == 0;
    __attribute__((address_space(3))) float* zb = (__attribute__((address_space(3))) float*)lds;
    u32x4 zv[6];
#pragma unroll
    for (int k = 0; k < 6; ++k) { const int id = tid + 512 * k; zv[k] = (u32x4){0u, 0u, 0u, 0u};
        if (id < 94 * 32) { const int row = id >> 5, c8 = id & 31; if (!(first && row < 30)) zv[k] = *(const u32x4*)(P + (long)(t0 - 30 + row) * PITCH + PC_Z + c8 * 8); } }
    const int c = tid & 255, half = tid >> 8;
    float wv[CONV_W]; const float bias = cb[c];
#pragma unroll
    for (int j = 0; j < CONV_W; ++j) wv[j] = cw[j * D_CONV + c];
    const f32x4 g4 = *(const f32x4*)(lg + 4 * lane), b4 = *(const f32x4*)(lb + 4 * lane);
    u32x2 gpre[8];
#pragma unroll
    for (int i = 0; i < 8; ++i) gpre[i] = *(const u32x2*)(P + (long)(t0 + wid * 8 + i) * PITCH + PC_G + 4 * lane);
    u32x2 uu[8], mm[8], gg[8];
    if (MB) {
#pragma unroll
        for (int i = 0; i < 8; ++i) { const long t = t0 + wid * 8 + i; uu[i] = *(const u32x2*)(P + t * PITCH + PC_U + 4 * lane); mm[i] = *(const u32x2*)(MB + t * 256 + 4 * lane); gg[i] = *(const u32x2*)(P + t * PITCH + PC_G + 768 + 4 * lane); } }
#pragma unroll
    for (int k = 0; k < 6; ++k) { const int id = tid + 512 * k;
        if (id < 94 * 32) { const int row = id >> 5, c8 = id & 31; const u32x4 v = zv[k];
            f32x4 a, b; a[0] = __uint_as_float(v.x << 16); a[1] = __uint_as_float(v.x & 0xffff0000u); a[2] = __uint_as_float(v.y << 16); a[3] = __uint_as_float(v.y & 0xffff0000u);
            b[0] = __uint_as_float(v.z << 16); b[1] = __uint_as_float(v.z & 0xffff0000u); b[2] = __uint_as_float(v.w << 16); b[3] = __uint_as_float(v.w & 0xffff0000u);
            *(__attribute__((address_space(3))) f32x4*)(zb + row * 256 + c8 * 8) = a; *(__attribute__((address_space(3))) f32x4*)(zb + row * 256 + c8 * 8 + 4) = b; } }
    MIX_LBAR();
    float acc[32];
#pragma unroll
    for (int t = 0; t < 32; ++t) acc[t] = bias;
    { float zr[62];
#pragma unroll
      for (int i = 0; i < 62; ++i) zr[i] = zb[(half * 32 + i) * 256 + c];
#pragma unroll
      for (int j = 0; j < CONV_W; ++j) { const float w = wv[j];
#pragma unroll
          for (int t = 0; t < 32; ++t) acc[t] = fmaf(w, zr[t + j], acc[t]); } }
    MIX_LBAR();
#pragma unroll
    for (int t = 0; t < 32; ++t) zb[(half * 32 + t) * 256 + c] = acc[t];
    MIX_LBAR();
    if (MB) {
#pragma unroll
        for (int i = 0; i < 8; ++i) { const long t = t0 + wid * 8 + i;
#define BFLO(x) __uint_as_float((x) << 16)
#define BFHI(x) __uint_as_float((x) & 0xffff0000u)
            u32x2 w; w.x = cvtpk(BFLO(uu[i].x) * BFLO(mm[i].x) * BFLO(gg[i].x), BFHI(uu[i].x) * BFHI(mm[i].x) * BFHI(gg[i].x)); w.y = cvtpk(BFLO(uu[i].y) * BFLO(mm[i].y) * BFLO(gg[i].y), BFHI(uu[i].y) * BFHI(mm[i].y) * BFHI(gg[i].y));
#undef BFLO
#undef BFHI
            *(u32x2*)(Y + t * 1024 + 768 + 4 * lane) = w; } }
    { f32x4 vv[8]; float s1[8], s2[8];
#pragma unroll
      for (int i = 0; i < 8; ++i) { vv[i] = *(const __attribute__((address_space(3))) f32x4*)(zb + (wid * 8 + i) * 256 + 4 * lane);
          s1[i] = (vv[i][0] + vv[i][1]) + (vv[i][2] + vv[i][3]); s2[i] = (vv[i][0] * vv[i][0] + vv[i][1] * vv[i][1]) + (vv[i][2] * vv[i][2] + vv[i][3] * vv[i][3]); }
#pragma unroll
      for (int i = 0; i < 8; ++i) { s1[i] = wave_sum(s1[i]); s2[i] = wave_sum(s2[i]); }
#pragma unroll
      for (int i = 0; i < 8; ++i) { const long t = t0 + wid * 8 + i;
          const float mean = s1[i] * (1.0f / 256.0f), var = fmaxf(s2[i] * (1.0f / 256.0f) - mean * mean, 0.f);
          const float rstd = __builtin_amdgcn_rsqf(var + EPS);
          const u32x2 g = gpre[i];
          const float gg_[4] = {__uint_as_float(g.x << 16), __uint_as_float(g.x & 0xffff0000u), __uint_as_float(g.y << 16), __uint_as_float(g.y & 0xffff0000u)};
          float o[4];
#pragma unroll
          for (int e = 0; e < 4; ++e) { const float yv = (vv[i][e] - mean) * rstd * g4[e] + b4[e]; o[e] = yv * __builtin_amdgcn_rcpf(1.0f + __builtin_amdgcn_exp2f(-LOG2E * yv)) * gg_[e]; }
          u32x2 w; w.x = cvtpk(o[0], o[1]); w.y = cvtpk(o[2], o[3]);
          *(u32x2*)(Y + t * 1024 + 4 * lane) = w; } }
    MIX_LBAR();
}
template <bool MIXONLY> __device__ __forceinline__ void sgu_unit(int chunk, const bf16* __restrict__ P, bf16* __restrict__ Y, const bf16* __restrict__ wst, const float* __restrict__ bs, const float* __restrict__ lg, const float* __restrict__ lb, lds_ptr lds) {
    int tid_ = threadIdx.x; asm volatile("" : "+v"(tid_));
    const int tid = tid_, lane = tid & 63, r32 = lane & 31, hi = lane >> 5; const int wid = __builtin_amdgcn_readfirstlane(tid >> 6), tb = wid & 3, g2 = wid >> 2;
    const long t0 = (long)chunk * 128;
    constexpr int BLKB = 128 * 64 + 64;
    const int nks = 2 * tb + 2;
    bf16x8 wf[2][8]; float bsv[2];
    const long t = t0 + 32 * tb + r32;
#pragma unroll
    for (int gi = 0; gi < 2; ++gi) { const int g = g2 + 2 * gi; bsv[gi] = bs[g * 128 + 32 * tb + r32];
#pragma unroll
        for (int ks = 0; ks < 8; ++ks) wf[gi][ks] = (ks < nks) ? *(const bf16x8*)(wst + ((size_t)g * 128 + 32 * tb + r32) * 128 + 16 * ks + 8 * hi) : (bf16x8){0, 0, 0, 0, 0, 0, 0, 0}; }
    { const f32x4 g4 = *(const f32x4*)(lg + 4 * lane), b4 = *(const f32x4*)(lb + 4 * lane);
      u32x2 rawv[16];
#pragma unroll
      for (int i = 0; i < 16; ++i) rawv[i] = *(const u32x2*)(P + (t0 + wid * 16 + i) * PITCH + PC_VV + 4 * lane);
      float s1[16], s2[16];
#pragma unroll
      for (int i = 0; i < 16; ++i) { const u32x2 raw = rawv[i];
          const float a0 = __uint_as_float(raw.x << 16), a1 = __uint_as_float(raw.x & 0xffff0000u), a2 = __uint_as_float(raw.y << 16), a3 = __uint_as_float(raw.y & 0xffff0000u);
          s1[i] = (a0 + a1) + (a2 + a3); s2[i] = (a0 * a0 + a1 * a1) + (a2 * a2 + a3 * a3); }
#pragma unroll
      for (int i = 0; i < 16; ++i) { s1[i] = wave_sum(s1[i]); s2[i] = wave_sum(s2[i]); }
      const lds_ptr wp = lds + (lane >> 3) * BLKB + (lane & 7) * 8;
#pragma unroll
      for (int i = 0; i < 16; ++i) { const u32x2 raw = rawv[i];
          const float mean = s1[i] * (1.0f / 256.0f), var = fmaxf(s2[i] * (1.0f / 256.0f) - mean * mean, 0.f), rstd = __builtin_amdgcn_rsqf(var + EPS);
          const float a[4] = {__uint_as_float(raw.x << 16), __uint_as_float(raw.x & 0xffff0000u), __uint_as_float(raw.y << 16), __uint_as_float(raw.y & 0xffff0000u)};
          u32x2 w; w.x = cvtpk((a[0] - mean) * rstd * g4[0] + b4[0], (a[1] - mean) * rstd * g4[1] + b4[1]); w.y = cvtpk((a[2] - mean) * rstd * g4[2] + b4[2], (a[3] - mean) * rstd * g4[3] + b4[3]);
          *(__attribute__((address_space(3))) u32x2*)(wp + (wid * 16 + i) * 64) = w; } }
    __syncthreads();
#pragma unroll
    for (int gi = 0; gi < 2; ++gi) { const int g = g2 + 2 * gi;
        u32x2 upre[2][4], gpre[2][4];
        if (!MIXONLY) {
#pragma unroll
            for (int db = 0; db < 2; ++db)
#pragma unroll
                for (int rq = 0; rq < 4; ++rq) { const int ch = g * 64 + 32 * db + 8 * rq + 4 * hi; upre[db][rq] = *(const u32x2*)(P + t * PITCH + PC_U + ch); gpre[db][rq] = *(const u32x2*)(P + t * PITCH + PC_G + 768 + ch); } }
        f32x16 acc[2]; acc[0] = f32x16{}; acc[1] = f32x16{};
        const lds_cptr vp = (lds_cptr)lds + (g * 2) * BLKB + ((lane >> 4) & 1) * 32 + (lane & 3) * 8 + (8 * hi + ((lane & 15) >> 2)) * 64;
#pragma unroll
        for (int ks = 0; ks < 8; ++ks) if (ks < nks) {
#pragma unroll
            for (int db = 0; db < 2; ++db) { const s16x4 lo = vtr(vp + db * BLKB + ks * 1024), hh = vtr(vp + db * BLKB + ks * 1024 + 256);
                acc[db] = __builtin_amdgcn_mfma_f32_32x32x16_bf16((bf16x8){lo[0], lo[1], lo[2], lo[3], hh[0], hh[1], hh[2], hh[3]}, wf[gi][ks], acc[db], 0, 0, 0); } }
#pragma unroll
        for (int db = 0; db < 2; ++db)
#pragma unroll
            for (int rq = 0; rq < 4; ++rq) { const int ch = g * 64 + 32 * db + 8 * rq + 4 * hi; const float bv = bsv[gi];
                const float m0 = acc[db][4 * rq] + bv, m1 = acc[db][4 * rq + 1] + bv, m2 = acc[db][4 * rq + 2] + bv, m3 = acc[db][4 * rq + 3] + bv;
                if (MIXONLY) { u32x2 w; w.x = cvtpk(m0, m1); w.y = cvtpk(m2, m3); *(u32x2*)(Y + t * 256 + ch) = w; }
                else { const u32x2 u = upre[db][rq], gt = gpre[db][rq];
                    u32x2 w; w.x = cvtpk(m0 * __uint_as_float(u.x << 16) * __uint_as_float(gt.x << 16), m1 * __uint_as_float(u.x & 0xffff0000u) * __uint_as_float(gt.x & 0xffff0000u));
                    w.y = cvtpk(m2 * __uint_as_float(u.y << 16) * __uint_as_float(gt.y << 16), m3 * __uint_as_float(u.y & 0xffff0000u) * __uint_as_float(gt.y & 0xffff0000u));
                    *(u32x2*)(Y + t * 1024 + 768 + ch) = w; } } }
    MIX_LBAR();
}
}
#ifndef REP_CS
#define REP_CS 1
#endif
#ifndef EARLY_SGU
#define EARLY_SGU 1
#endif
#ifndef STATIC_CONV
#define STATIC_CONV 0
#endif
#ifndef ATT_VAR
#define ATT_VAR 0
#endif
#ifndef DRY_VAR
#define DRY_VAR -1
#endif
#ifndef MIX_ATTN
#define MIX_ATTN 1
#endif
#ifndef MIX_CONV
#define MIX_CONV 1
#endif
#ifndef MIX_SGU
#define MIX_SGU 1
#endif
#define RUN_QUEUE(lq, maxn) do { const int lyr_ = (lq) & 1; volatile LAS int* qs_ = (volatile LAS int*)(F.lds + RING_OFF + mix::A_LDS_SCH + 4096 + 64); \
        for (int qn_ = 0; qn_ < (maxn); ++qn_) { MIX_LBAR(); if (F.tid == 0) qs_[0] = (int)__hip_atomic_fetch_add((unsigned*)(F.ctl + CW_QUEUE) + 16 * (lq), 1u, __ATOMIC_RELAXED, __HIP_MEMORY_SCOPE_AGENT); MIX_LBAR(); \
            const int qi_ = qs_[0] + (STATIC_CONV ? 256 : 0); if (qi_ >= (EARLY_SGU ? 256 : 384)) break; \
            if (qi_ < 256) mix::conv_unit(qi_, (const bf16*)(ws + WS_PROJ), EARLY_SGU ? (const bf16*)(ws + WS_MIXB) : (const bf16*)nullptr, (bf16*)(ws + WS_Y), args.in[I_CONVW] + lyr_ * CONV_W * D_CONV, args.in[I_CONVB] + lyr_ * D_CONV, args.in[I_CLNG] + lyr_ * D_CONV, args.in[I_CLNB] + lyr_ * D_CONV, F.lds + RING_OFF); \
            else mix::sgu_unit<false>(qi_ - 256, (const bf16*)(ws + WS_PROJ), (bf16*)(ws + WS_Y), (const bf16*)(ws + WS_WST) + (size_t)lyr_ * NG * CHUNK * CHUNK, args.in[I_BS] + lyr_ * NG * CHUNK, args.in[I_SLNG] + lyr_ * D_SGU, args.in[I_SLNB] + lyr_ * D_SGU, F.lds + RING_OFF); } } while (0)
#if STATIC_CONV
#define QUEUE_PROLOG(l) mix::conv_unit(F.vcu, (const bf16*)(ws + WS_PROJ), (const bf16*)nullptr, (bf16*)(ws + WS_Y), args.in[I_CONVW] + (l) * CONV_W * D_CONV, args.in[I_CONVB] + (l) * D_CONV, args.in[I_CLNG] + (l) * D_CONV, args.in[I_CLNB] + (l) * D_CONV, F.lds + RING_OFF)
#else
#define QUEUE_PROLOG(l) do { } while (0)
#endif
#define MIXERS_PHASE(l) do { \
    if (MIX_ATTN) { \
        float s1_ = 0.f, s2_ = 0.f; for (int i_ = 0; i_ < QKD; ++i_) { s1_ += args.in[I_LQ1][(l) * QKD + i_] * args.in[I_LK1][(l) * QKD + i_]; s2_ += args.in[I_LQ2][(l) * QKD + i_] * args.in[I_LK2][(l) * QKD + i_]; } \
        const float lam_init_ = 0.8f - 0.6f * __expf(-0.3f * (float)(l)); const float lam_ = __expf(s1_) - __expf(s2_) + lam_init_; \
        mix::attn_phase<ATT_VAR>((l), F.vcu, (const unsigned*)(F.ctl + CW_NRM) + (l) * 64, (float*)(ws + WS_SLAB), (unsigned*)(F.ctl + CW_FLAG), (const bf16*)(ws + WS_PROJ), (const bf16*)(ws + WS_KT), (const bf16*)(ws + WS_VT), (bf16*)(ws + WS_Y), lam_, F.lds + RING_OFF, 0); \
        if (DRY_VAR >= 0) mix::attn_phase<(DRY_VAR < 0 ? 0 : DRY_VAR)>((l), F.vcu, (const unsigned*)(F.ctl + CW_NRM) + (l) * 64, (float*)(ws + WS_SLAB), (unsigned*)(F.ctl + CW_FLAG), (const bf16*)(ws + WS_PROJ), (const bf16*)(ws + WS_KT), (const bf16*)(ws + WS_VT), (bf16*)(ws + WS_Y), lam_, F.lds + RING_OFF, args.dry); } \
    STAMP(10 + 4 * (l)); \
    if (MIX_CONV && MIX_SGU) { QUEUE_PROLOG(l); RUN_QUEUE(l, 1024); for (int rq_ = 1; rq_ < REP_CS; ++rq_) { RUN_QUEUE((l) + 2 * rq_, 1024); } } \
    else { if (MIX_CONV) mix::conv_unit(F.vcu, (const bf16*)(ws + WS_PROJ), (const bf16*)nullptr, (bf16*)(ws + WS_Y), args.in[I_CONVW] + (l) * CONV_W * D_CONV, args.in[I_CONVB] + (l) * D_CONV, args.in[I_CLNG] + (l) * D_CONV, args.in[I_CLNB] + (l) * D_CONV, F.lds + RING_OFF); \
        if (MIX_SGU) mix::sgu_unit<false>(F.vcu, (const bf16*)(ws + WS_PROJ), (bf16*)(ws + WS_Y), (const bf16*)(ws + WS_WST) + (size_t)(l) * NG * CHUNK * CHUNK, args.in[I_BS] + (l) * NG * CHUNK, args.in[I_SLNG] + (l) * D_SGU, args.in[I_SLNB] + (l) * D_SGU, F.lds + RING_OFF); } \
    } while (0)

constexpr size_t MiB = 1u << 20;
constexpr size_t WS_CTL = 0, CTL_ZERO_BYTES = 64 * 1024;
constexpr size_t WS_SSQP = 1 * MiB;
constexpr size_t WS_XCHG = 1 * MiB + 512 * 1024;
constexpr size_t WS_WST = 2 * MiB;
constexpr size_t WS_WIN = 4 * MiB;
constexpr size_t WS_WOUT = 18 * MiB;
constexpr size_t WS_XB = 22 * MiB;
constexpr size_t WS_PROJ = 54 * MiB;
constexpr size_t WS_KT = 126 * MiB, WS_VT = 142 * MiB;
constexpr size_t WS_Y = 166 * MiB;
constexpr size_t WS_DBG_D = 198 * MiB;
constexpr size_t WS_SLAB = 198 * MiB;
constexpr size_t WS_DBG_VV = 236 * MiB;
constexpr size_t WS_MIXB = 236 * MiB;
constexpr int CW_NRM = 8192;
constexpr int CW_R1 = 13632;
constexpr int CW_XID = 15360;
constexpr int CW_QUEUE = 13568;
constexpr int CW_PANEL = 12544;
constexpr int CW_FLAG = 8448;
constexpr int CW_BAR = 4096;
static_assert((CW_BAR + 3456) <= CW_NRM && (CW_FLAG + 256 * 16) <= CW_PANEL && (CW_PANEL + 64 * 16) <= CW_QUEUE && (CW_QUEUE + 4 * 16) <= CW_R1 && (CW_R1 + 64 * 16) * 4 <= (int)CTL_ZERO_BYTES, "CTL words inside the memset region");

constexpr int RING_OFF = 0, RING_BYTES = 159744;
constexpr int LDSCTL_OFF = RING_BYTES, MISC_OFF = LDSCTL_OFF + 320;
constexpr int LDS_BYTES = 163840;
constexpr int NWAVES = 8;

struct Args {
    const float* in[18]; float* out; unsigned char* ws; int ph_lo, ph_hi, dry, pad;
};
enum { I_X = 0, I_NORMG, I_WIN, I_CONVW, I_CONVB, I_CLNG, I_CLNB, I_LQ1, I_LK1, I_LQ2, I_LK2, I_SUBG, I_SLNG, I_SLNB, I_WS, I_BS, I_WOUT, I_NORMF };

__device__ __forceinline__ float wave_sum(float x) { return mix::wave_sum(x); }
__device__ __forceinline__ float bf2f(unsigned short v) { return __uint_as_float((unsigned)v << 16); }

__host__ __device__ __forceinline__ int win_colmap(int np) { const int pt = tile_role(np >> 8), j = np & 255;
    switch (pt) { case 0: case 1: return (j < 128) ? (128 * pt + j) : (256 + 128 * pt + (j - 128));
        case 2: return 2048 + j; case 3: return 2304 + j; case 4: return 2560 + j; case 5: return 2560 + 768 + j;
        case 6: case 7: return 512 + (pt - 6) * 256 + j; case 8: case 9: return 1024 + (pt - 8) * 256 + j; case 10: case 11: return 1536 + (pt - 10) * 256 + j;
        default: return 2560 + 256 + (pt - 12) * 256 + j; } }

__device__ __forceinline__ void p0_transpose_item(const float* W, int K, int N, bf16* WT, const float* gain, bool permute, LAS float* scr, int item, int lane, float hscale = 0.f) {
    const int nblk = N / 32, kb = item / nblk, nb = item % nblk, k0 = 64 * kb, n0 = 32 * nb;
    const int s0 = permute ? win_colmap(n0) : n0;
    float wv[32];
#pragma unroll
    for (int i = 0; i < 32; ++i) wv[i] = __builtin_nontemporal_load(W + (size_t)(k0 + 2 * i + (lane >> 5)) * N + s0 + (lane & 31));
#pragma unroll
    for (int i = 0; i < 32; ++i) { const int kk = 2 * i + (lane >> 5); float v = wv[i]; if (hscale != 0.f) { const int k_ = k0 + kk; if (k_ >= 256 && k_ < 768) v *= gain[k_ & 127] * hscale; } else if (gain) v *= gain[k0 + kk]; scr[kk * 33 + (lane & 31)] = v; }
    LDS_WAIT(); asm volatile("" ::: "memory");
    const int c = lane & 7;
#pragma unroll
    for (int j = 0; j < 4; ++j) { const int n = (lane >> 3) + 8 * j; const LAS float* s = scr + (8 * c) * 33 + n;
        v4u o; o.x = pk2(s[0 * 33], s[1 * 33]); o.y = pk2(s[2 * 33], s[3 * 33]); o.z = pk2(s[4 * 33], s[5 * 33]); o.w = pk2(s[6 * 33], s[7 * 33]);
        *(GAS v4u*)(WT + (size_t)(n0 + n) * K + k0 + 8 * c) = o; }
    LDS_WAIT(); asm volatile("" ::: "memory");
}

struct Frame {
    LAS unsigned char* lds;
    volatile LAS unsigned* MISC;
    gu32* ctl;
    int tid, lane, wave, vcu, G;
};

__device__ __forceinline__ void p0_prologue(Frame& F, const Args& a) {
    int lane_ = F.lane; asm volatile("" : "+v"(lane_));
    LAS float* scr = (LAS float*)(F.lds + RING_OFF + F.wave * 16384);
    const int gw = F.vcu * NWAVES + F.wave, NGW = F.G * NWAVES;
    unsigned char* ws = a.ws;
    constexpr int I_IN = (D_MODEL / 64) * (D_IN / 32);
    for (int it = gw; it < I_IN; it += NGW)
        p0_transpose_item(a.in[I_WIN], D_MODEL, D_IN, (bf16*)(ws + WS_WIN), a.in[I_NORMG], true, scr, it, lane_);
    { bf16* wst = (bf16*)(ws + WS_WST); const float* w = a.in[I_WS];
      for (int i = gw * 64 + lane_; i < DEPTH * NG * CHUNK * CHUNK; i += NGW * 64) { const int s = i & 127, t = (i >> 7) & 127; wst[i] = (bf16)f2bf(s <= t ? w[i] : 0.f); } }
    { const float* x = a.in[I_X]; bf16* xb = (bf16*)(ws + WS_XB); float* ssqp = (float*)(ws + WS_SSQP);
      for (int m = gw; m < M_TOK; m += 4 * NGW) {
          f32x4 v[4][4]; float s[4];
#pragma unroll
          for (int r = 0; r < 4; ++r) { const GAS f32x4* xr = (const GAS f32x4*)(x + (size_t)(m + r * NGW) * D_MODEL) + lane_;
#pragma unroll
              for (int j = 0; j < 4; ++j) v[r][j] = __builtin_nontemporal_load(xr + 64 * j); }
#pragma unroll
          for (int r = 0; r < 4; ++r) { float t = 0.f;
#pragma unroll
              for (int j = 0; j < 4; ++j) t += (v[r][j].x * v[r][j].x + v[r][j].y * v[r][j].y) + (v[r][j].z * v[r][j].z + v[r][j].w * v[r][j].w);
              s[r] = wave_sum(t); }
#pragma unroll
          for (int r = 0; r < 4; ++r) { GAS unsigned long long* o8 = (GAS unsigned long long*)(xb + (size_t)(m + r * NGW) * D_MODEL) + lane_;
#pragma unroll
              for (int j = 0; j < 4; ++j) o8[64 * j] = (unsigned long long)pk2(v[r][j].x, v[r][j].y) | ((unsigned long long)pk2(v[r][j].z, v[r][j].w) << 32);
              if (lane_ < 4) ssqp[(size_t)lane_ * M_TOK + m + r * NGW] = (lane_ == 0) ? s[r] : 0.f; }
      } }
}
__device__ __forceinline__ void late_convert(Frame& F, const Args& a, int rank, int nwg, int part) {
    int lane_ = F.lane; asm volatile("" : "+v"(lane_));
    LAS float* scr = (LAS float*)(F.lds + RING_OFF + F.wave * 16384);
    const int gw = rank * NWAVES + F.wave, NGW = nwg * NWAVES;
    unsigned char* ws = a.ws;
    constexpr int I_IN = (D_MODEL / 64) * (D_IN / 32), I_OUT = (D_MIX / 64) * (D_MODEL / 32);
    const int it_lo = (part == 1) ? I_IN + I_OUT : 0, it_hi = (part == 0) ? I_IN + I_OUT : I_IN + 2 * I_OUT;
    for (int it = it_lo + gw; it < it_hi; it += NGW) {
        int r = it;
        if (r < I_IN) { p0_transpose_item(a.in[I_WIN] + (size_t)D_MODEL * D_IN, D_MODEL, D_IN, (bf16*)(ws + WS_WIN) + (size_t)D_IN * D_MODEL, a.in[I_NORMG] + D_MODEL, true, scr, r, lane_); continue; }
        r -= I_IN;
        { const int l = r / I_OUT; r -= l * I_OUT;
            p0_transpose_item(a.in[I_WOUT] + (size_t)l * D_MIX * D_MODEL, D_MIX, D_MODEL, (bf16*)(ws + WS_WOUT) + (size_t)l * D_MODEL * D_MIX, a.in[I_SUBG] + l * VD, false, scr, r, lane_, 1.0f - (0.8f - 0.6f * __expf(-0.3f * (float)l))); }
    }
}

__device__ __forceinline__ void final_norm(Frame& F, const Args& a) {
    const int gw = F.vcu * NWAVES + F.wave, NGW = F.G * NWAVES;
    const GAS f32x4* g4 = (const GAS f32x4*)a.in[I_NORMF] + F.lane;
    for (int m = gw; m < M_TOK; m += NGW) {
        GAS f32x4* xr = (GAS f32x4*)(a.out + (size_t)m * D_MODEL) + F.lane;
        f32x4 v[4]; float s = 0.f;
#pragma unroll
        for (int j = 0; j < 4; ++j) { v[j] = xr[64 * j]; s += (v[j].x * v[j].x + v[j].y * v[j].y) + (v[j].z * v[j].z + v[j].w * v[j].w); }
        s = wave_sum(s);
        const float r = 1.0f / sqrtf(s * (1.0f / D_MODEL) + EPS);
#pragma unroll
        for (int j = 0; j < 4; ++j) xr[64 * j] = v[j] * r * g4[64 * j];
    }
}

#ifndef EARLY0
#define EARLY0 1
#endif
#ifndef EARLY1
#define EARLY1 2
#endif
#define EARLY_UNITS(l) ((l) == 0 ? EARLY0 : EARLY1)
#ifndef PANEL_SYNC
#define PANEL_SYNC 1
#endif
#ifndef RES_BF16
#define RES_BF16 1
#endif
#ifndef REP_PRO
#define REP_PRO 1
#endif
#ifndef REP_OUT0
#define REP_OUT0 1
#endif
#ifndef REP_IN
#define REP_IN 1
#endif
#ifndef REP_MIX
#define REP_MIX 1
#endif
constexpr int N_PHASES = 8;
__global__ void __launch_bounds__(NWAVES * 64, 2) mk_fwd(Args args) {
    extern __shared__ __attribute__((aligned(16))) unsigned char lds[];
    Frame F;
    F.lds = (LAS unsigned char*)lds;
    F.MISC = (volatile LAS unsigned*)(F.lds + MISC_OFF);
    F.tid = threadIdx.x; F.lane = F.tid & 63; F.wave = __builtin_amdgcn_readfirstlane(F.tid >> 6);
    F.G = gridDim.x; { const int bx = blockIdx.x; F.vcu = (F.G % 8 == 0) ? (bx % 8) * (F.G / 8) + bx / 8 : bx; }
    unsigned char* ws = args.ws;
    F.ctl = (gu32*)(ws + WS_CTL);
    if (F.tid == 0) __hip_atomic_store((unsigned*)(F.ctl + CW_XID) + blockIdx.x, xb_xcc_id() + 1u, __ATOMIC_RELAXED, __HIP_MEMORY_SCOPE_AGENT);
    for (int u = F.tid; u < (LDS_BYTES - LDSCTL_OFF) / 4; u += NWAVES * 64) ((LAS unsigned*)(F.lds + LDSCTL_OFF))[u] = 0u;
    __syncthreads();
    const int lo = args.ph_lo, hi = args.ph_hi;
#ifdef PROBE_PHASE
#ifndef PROBE_BLK
#define PROBE_BLK 0
#endif
#define STAMP(k) do { if (blockIdx.x == PROBE_BLK && F.tid == 0) ((volatile LAS unsigned long long*)(F.lds + MISC_OFF + 128))[(k)] = __builtin_amdgcn_s_memrealtime(); } while (0)
    STAMP(0);
#else
#define STAMP(k) do { } while (0)
#endif
    XcdBarrier bar; bar.bar = (unsigned*)(F.ctl + CW_BAR); bar.x = 0; bar.st = nullptr;
    if (hi - lo > 1) bar = xcd_barrier_post((unsigned*)(F.ctl + CW_BAR), F.MISC + 8);
#define IN(k) (lo <= (k) && (k) < hi)
#define BOTH(k) (IN(k) && IN((k) + 1))
    if (IN(0)) {
#ifndef NO_PRO
 for (int rep_ = 0; rep_ < REP_PRO; ++rep_) p0_prologue(F, args);
#endif
 if (BOTH(0)) { xcd_barrier(bar);
     if (F.tid == 0) { const unsigned me_ = xb_xcc_id() + 1u; bool same_ = true;
         for (int k_ = 0; k_ < 4; ++k_) same_ = same_ && (__hip_atomic_load((unsigned*)(F.ctl + CW_XID) + ((int)blockIdx.x & 63) + 64 * k_, __ATOMIC_RELAXED, __HIP_MEMORY_SCOPE_AGENT) == me_);
         F.MISC[12] = same_ ? 1u : 0u; } }
 STAMP(1); }
    for (int l = 0; l < DEPTH; ++l) {
        const int pb = 1 + 3 * l;
        if (IN(pb)) {
            if (l == 1 && PANEL_SYNC && IN(pb - 1) && F.G == 256) {
                const int c_ = (int)blockIdx.x, pm_ = 8 * (c_ & 7) + ((c_ >> 3) & 7);
                if (F.wave == 0) { unsigned spins_ = 0;
                    while ((unsigned)__builtin_amdgcn_readfirstlane(__hip_atomic_load((unsigned*)(F.ctl + CW_R1) + 16 * pm_, __ATOMIC_RELAXED, __HIP_MEMORY_SCOPE_AGENT)) < 4u) { __builtin_amdgcn_s_sleep(2); if (++spins_ > (1u << 22)) break; }
                    __builtin_amdgcn_fence(__ATOMIC_ACQUIRE, "agent"); asm volatile("s_waitcnt vmcnt(0)" ::: "memory"); }
                __syncthreads();
            }
#ifndef NO_IN
            pg8::Gemm g{(const bf16*)(ws + WS_XB), (const bf16*)(ws + WS_WIN) + (size_t)l * D_IN * D_MODEL, M_TOK, D_IN, D_MODEL};
            pg8::StaticOrder S; S.init(M_TOK, D_IN, F.G, (int)blockIdx.x);
            pg8::EpiIn E{(bf16*)(ws + WS_PROJ), (const float*)(ws + WS_SSQP), (unsigned*)(F.ctl + CW_NRM) + l * 64, (bf16*)(ws + WS_KT), (bf16*)(ws + WS_VT)};
            for (int rep_ = 0; rep_ < REP_IN; ++rep_)
            pg8::gemm_phase<pg8::EpiIn, pg8::StaticOrder, true, true>(F.lds + RING_OFF, g, S, E);
#endif
            if (F.G == 256) { if (blockIdx.x >= 128 && (!EARLY_SGU || blockIdx.x < 192)) late_convert(F, args, (int)blockIdx.x - 128, EARLY_SGU ? 64 : 128, l); }
            else if (l == 0) late_convert(F, args, (int)blockIdx.x, F.G, 2);
            STAMP(20);
            if (EARLY_SGU && F.G == 256 && blockIdx.x >= 192) {
                const int c_ = (int)blockIdx.x, pm_ = 8 * (c_ & 7) + ((c_ >> 3) & 7);
                for (int k_ = 0; k_ < 2; ++k_)
                    mix::sgu_unit<true>(2 * pm_ + k_, (const bf16*)(ws + WS_PROJ), (bf16*)(ws + WS_MIXB), (const bf16*)(ws + WS_WST) + (size_t)l * NG * CHUNK * CHUNK, args.in[I_BS] + l * NG * CHUNK, args.in[I_SLNG] + l * D_SGU, args.in[I_SLNB] + l * D_SGU, F.lds + RING_OFF);
            }
            STAMP(21);
            if (BOTH(pb)) xcd_barrier(bar);
            STAMP(pb + 1);
        }
        if (IN(pb + 1)) {
            for (int rep_ = 0; rep_ < REP_MIX; ++rep_) { MIXERS_PHASE(l); }
            if (BOTH(pb + 1)) xcd_barrier(bar);
            STAMP(pb + 2);
        }
        if (IN(pb + 2)) {
#ifndef NO_OUT
            pg8::Gemm g{(const bf16*)(ws + WS_Y), (const bf16*)(ws + WS_WOUT) + (size_t)l * D_MODEL * D_MIX, M_TOK, D_MODEL, D_MIX};
            pg8::StaticOrder S; S.init(M_TOK, D_MODEL, F.G, (int)blockIdx.x);
            if (l == 0 && PANEL_SYNC && BOTH(pb + 2) && F.G == 256) {
                const bool wt_ = __builtin_amdgcn_readfirstlane((int)F.MISC[12]) == 0;
                pg8::EpiOutP E{(bf16*)(ws + WS_XB), (float*)(ws + WS_SSQP), (unsigned*)(F.ctl + CW_R1), ws, wt_};
                pg8::gemm_phase<pg8::EpiOutP, pg8::StaticOrder, false, true>(F.lds + RING_OFF, g, S, E); }
            else if (l == 0) { pg8::EpiOut E{RES_BF16 ? (const float*)nullptr : args.in[I_X], nullptr, (bf16*)(ws + WS_XB), (float*)(ws + WS_SSQP)};
                for (int rep_ = 0; rep_ < REP_OUT0; ++rep_)
                pg8::gemm_phase<pg8::EpiOut, pg8::StaticOrder, false, true>(F.lds + RING_OFF, g, S, E); }
            else { pg8::EpiOutFinal E{(const bf16*)(ws + WS_XB), args.out, args.in[I_NORMF], (float*)(ws + WS_XCHG), (unsigned*)(F.ctl + CW_PANEL)};
                pg8::gemm_phase<pg8::EpiOutFinal, pg8::StaticOrder, false, true>(F.lds + RING_OFF, g, S, E); }
#endif
            if (BOTH(pb + 2) && l == 0 && !(PANEL_SYNC && F.G == 256)) xcd_barrier(bar);
            STAMP(pb + 3);
        }
    }
#ifdef PROBE_PHASE
#ifndef PROBE_A
#define PROBE_A PROBE_PHASE
#define PROBE_B (PROBE_PHASE + 1)
#endif
    STAMP(8);
    if (blockIdx.x == PROBE_BLK && F.tid == 0) { const unsigned long long dt = ((volatile LAS unsigned long long*)(F.lds + MISC_OFF + 128))[PROBE_B] - ((volatile LAS unsigned long long*)(F.lds + MISC_OFF + 128))[PROBE_A];
        const unsigned long long t0_ = __builtin_amdgcn_s_memrealtime(); while (__builtin_amdgcn_s_memrealtime() - t0_ < (unsigned long long)PROBE_K * dt) __builtin_amdgcn_s_sleep(8); }
#endif
#undef IN
#undef BOTH
}

namespace naive {
__device__ __forceinline__ float sigmoidf_(float x) { return 1.f / (1.f + __expf(-x)); }
__device__ __forceinline__ float siluf_(float x) { return x / (1.f + __expf(-x)); }
__device__ __forceinline__ bf16 tobf(float f) { return (bf16)f2bf(f); }

__global__ void __launch_bounds__(256) k_prologue(Args a) {
    unsigned char* ws = a.ws;
    const size_t gid = (size_t)blockIdx.x * 256 + threadIdx.x, gsz = (size_t)gridDim.x * 256;
    for (int l = 0; l < DEPTH; ++l) {
        bf16* wt = (bf16*)(ws + WS_WIN) + (size_t)l * D_IN * D_MODEL; const float* w = a.in[I_WIN] + (size_t)l * D_MODEL * D_IN; const float* g = a.in[I_NORMG] + l * D_MODEL;
        for (size_t i = gid; i < (size_t)D_IN * D_MODEL; i += gsz) { const int np = (int)(i / D_MODEL), k = (int)(i % D_MODEL); wt[i] = tobf(w[(size_t)k * D_IN + win_colmap(np)] * g[k]); }
        bf16* wo = (bf16*)(ws + WS_WOUT) + (size_t)l * D_MODEL * D_MIX; const float* w2 = a.in[I_WOUT] + (size_t)l * D_MIX * D_MODEL;
        for (size_t i = gid; i < (size_t)D_MODEL * D_MIX; i += gsz) { const int n = (int)(i / D_MIX), k = (int)(i % D_MIX); float v = w2[(size_t)k * D_MODEL + n]; if (k >= 256 && k < 768) v *= a.in[I_SUBG][l * VD + (k & 127)] * (1.0f - (0.8f - 0.6f * __expf(-0.3f * (float)l))); wo[i] = tobf(v); }
    }
    bf16* wst = (bf16*)(ws + WS_WST); const float* w = a.in[I_WS];
    for (size_t i = gid; i < (size_t)DEPTH * NG * CHUNK * CHUNK; i += gsz) { const int s = (int)(i & 127), t = (int)((i >> 7) & 127); wst[i] = tobf(s <= t ? w[i] : 0.f); }
}
__global__ void __launch_bounds__(256) k_rowstats(const float* x, bf16* xb, float* ssqp) {
    const int m = (blockIdx.x * 256 + threadIdx.x) >> 6, lane = threadIdx.x & 63;
    float s = 0.f;
    for (int j = 0; j < 16; ++j) { const float v = x[(size_t)m * D_MODEL + lane + 64 * j]; s += v * v; xb[(size_t)m * D_MODEL + lane + 64 * j] = tobf(v); }
    s = wave_sum(s);
    if (lane < 4) ssqp[(size_t)lane * M_TOK + m] = lane == 0 ? s : 0.f;
}
template <int MODE>
__global__ void __launch_bounds__(256) k_gemm(const bf16* __restrict__ A, const bf16* __restrict__ Bt, int M, int N, int K, bf16* P, const float* ssqp, const float* base, float* out, bf16* KT, bf16* VT, bf16* GT) {
    __shared__ float As[16][68];
    __shared__ float Bs[16][68];
    const int tx = threadIdx.x & 15, ty = threadIdx.x >> 4;
    const int m0 = blockIdx.y * 64, n0 = blockIdx.x * 64;
    float acc[4][4];
#pragma unroll
    for (int i = 0; i < 4; ++i)
#pragma unroll
        for (int j = 0; j < 4; ++j) acc[i][j] = 0.f;
    for (int k0 = 0; k0 < K; k0 += 16) {
        { const int r = threadIdx.x >> 2, c = (threadIdx.x & 3) * 4;
          const ushort4 av = *(const ushort4*)(A + (size_t)(m0 + r) * K + k0 + c);
          As[c + 0][r] = bf2f(av.x); As[c + 1][r] = bf2f(av.y); As[c + 2][r] = bf2f(av.z); As[c + 3][r] = bf2f(av.w);
          const ushort4 bv = *(const ushort4*)(Bt + (size_t)(n0 + r) * K + k0 + c);
          Bs[c + 0][r] = bf2f(bv.x); Bs[c + 1][r] = bf2f(bv.y); Bs[c + 2][r] = bf2f(bv.z); Bs[c + 3][r] = bf2f(bv.w); }
        __syncthreads();
#pragma unroll
        for (int kk = 0; kk < 16; ++kk) {
            float a[4], b[4];
#pragma unroll
            for (int i = 0; i < 4; ++i) a[i] = As[kk][ty * 4 + i];
#pragma unroll
            for (int j = 0; j < 4; ++j) b[j] = Bs[kk][tx * 4 + j];
#pragma unroll
            for (int i = 0; i < 4; ++i)
#pragma unroll
                for (int j = 0; j < 4; ++j) acc[i][j] = fmaf(a[i], b[j], acc[i][j]);
        }
        __syncthreads();
    }
#pragma unroll
    for (int i = 0; i < 4; ++i) {
        const int m = m0 + ty * 4 + i;
        if (MODE == 0) {
            const float s = ssqp[m] + ssqp[M_TOK + m] + ssqp[2 * M_TOK + m] + ssqp[3 * M_TOK + m];
            const float r = rsqrtf(s * (1.f / D_MODEL) + EPS);
#pragma unroll
            for (int j = 0; j < 4; ++j) { const int sc_ = win_colmap(n0 + tx * 4 + j); const float v = acc[i][j] * r;
                if (sc_ < 256) P[(size_t)m * PPITCH + PC_Z + sc_] = tobf(v); else if (sc_ < 512) GT[(size_t)m * 1024 + (sc_ - 256)] = tobf(v);
                else if (sc_ < 1024) P[(size_t)m * PPITCH + PC_Q + (sc_ - 512)] = tobf(v * C2);
                else if (sc_ < 1536) KT[kt_off(m, sc_ - 1024)] = tobf(v);
                else if (sc_ < 2048) VT[vt_off(m, sc_ - 1536)] = tobf(v);
                else if (sc_ < 2560) P[(size_t)m * PPITCH + PC_U + (sc_ - 2048)] = tobf(v);
                else P[(size_t)m * PPITCH + PC_G + (sc_ - 2560)] = tobf(siluf_(v)); }
        } else {
#pragma unroll
            for (int j = 0; j < 4; ++j) { const size_t off = (size_t)m * N + n0 + tx * 4 + j; out[off] = (base ? base[off] : bf2f(GT[off])) + acc[i][j]; }
        }
    }
}
__global__ void __launch_bounds__(256) k_glu(bf16* P, const bf16* GT) {
    const int t = blockIdx.x, c = threadIdx.x;
    const float a = bf2f(P[(size_t)t * PPITCH + PC_Z + c]), g = bf2f(GT[(size_t)t * 1024 + c]);
    P[(size_t)t * PPITCH + PC_Z + c] = tobf(a * sigmoidf_(g));
}
__global__ void __launch_bounds__(256) k_conv(const bf16* __restrict__ P, const float* __restrict__ cw, const float* __restrict__ cb, const float* __restrict__ lg, const float* __restrict__ lb, bf16* __restrict__ Y) {
    __shared__ float red[8];
    const int t = blockIdx.x, c = threadIdx.x, tb = t & (SEQ - 1);
    float acc = cb[c];
    for (int j = 0; j < CONV_W; ++j) { const int d = j - (CONV_W - 1); if (tb + d >= 0) acc = fmaf(cw[j * D_CONV + c], bf2f(P[(size_t)(t + d) * PPITCH + PC_Z + c]), acc); }
    float s = wave_sum(acc);
    if ((c & 63) == 0) red[c >> 6] = s;
    __syncthreads();
    const float mean = (red[0] + red[1] + red[2] + red[3]) * (1.f / D_CONV);
    const float d = acc - mean;
    float q = wave_sum(d * d);
    if ((c & 63) == 0) red[4 + (c >> 6)] = q;
    __syncthreads();
    const float var = (red[4] + red[5] + red[6] + red[7]) * (1.f / D_CONV);
    const float yv = d * rsqrtf(var + EPS) * lg[c] + lb[c];
    Y[(size_t)t * D_MIX + c] = tobf(siluf_(yv) * bf2f(P[(size_t)t * PPITCH + PC_G + c]));
}
__global__ void __launch_bounds__(64) k_attn(const bf16* __restrict__ P, const bf16* __restrict__ KT, const bf16* __restrict__ VT, const float* __restrict__ lq1, const float* __restrict__ lk1, const float* __restrict__ lq2, const float* __restrict__ lk2, float lam_init, float* __restrict__ Dd) {
    const int q = blockIdx.x * 64 + threadIdx.x;
    const int b = blockIdx.y >> 5, h = (blockIdx.y >> 3) & 3, vp = blockIdx.y & 7;
    const float sl2 = exp2f(-8.f * (float)(h + 1) / (float)NH) * LOG2E;
    float s1 = 0.f, s2 = 0.f;
    for (int i = 0; i < QKD; ++i) { s1 += lq1[i] * lk1[i]; s2 += lq2[i] * lk2[i]; }
    const float lam = __expf(s1) - __expf(s2) + lam_init;
    const size_t rb = (size_t)b * SEQ;
    float q0[QKD], q1[QKD];
    const bf16* qp = P + (rb + q) * PPITCH + PC_Q + h * 128;
#pragma unroll
    for (int d = 0; d < QKD; ++d) { q0[d] = bf2f(qp[d]); q1[d] = bf2f(qp[64 + d]); }
    float o0[16], o1[16];
#pragma unroll
    for (int d = 0; d < 16; ++d) { o0[d] = 0.f; o1[d] = 0.f; }
    float m0 = -1e30f, l0 = 0.f, m1 = -1e30f, l1 = 0.f;
    const int kmax = blockIdx.x * 64 + 63;
    for (int k = 0; k <= kmax; ++k) {
        float a0 = 0.f, a1 = 0.f;
#pragma unroll
        for (int d = 0; d < QKD; ++d) { a0 = fmaf(q0[d], bf2f(KT[kt_off((int)rb + k, h * 128 + d)]), a0); a1 = fmaf(q1[d], bf2f(KT[kt_off((int)rb + k, h * 128 + 64 + d)]), a1); }
        const float bias = sl2 * (float)(k - q);
        a0 += bias; a1 += bias;
        if (k <= q) {
            const float n0 = fmaxf(m0, a0), n1 = fmaxf(m1, a1);
            const float f0 = exp2f(m0 - n0), p0 = exp2f(a0 - n0), f1 = exp2f(m1 - n1), p1 = exp2f(a1 - n1);
            l0 = l0 * f0 + p0; l1 = l1 * f1 + p1;
#pragma unroll
            for (int d = 0; d < 16; ++d) { const float v = bf2f(VT[vt_off((int)rb + k, h * 128 + vp * 16 + d)]); o0[d] = fmaf(o0[d], f0, p0 * v); o1[d] = fmaf(o1[d], f1, p1 * v); }
            m0 = n0; m1 = n1;
        }
    }
    const float i0 = 1.f / l0, i1 = lam / l1;
    float* op = Dd + (rb + q) * D_ATTN + h * 128 + vp * 16;
#pragma unroll
    for (int d = 0; d < 16; ++d) op[d] = o0[d] * i0 - o1[d] * i1;
}
__global__ void __launch_bounds__(512) k_attn_combine(const float* __restrict__ Dd, const bf16* __restrict__ P, const float* __restrict__ subg, float lam_init, bf16* __restrict__ Y) {
    __shared__ float red[8];
    const int t = blockIdx.x, c = threadIdx.x;
    const float o = Dd[(size_t)t * D_ATTN + c];
    const float ss = wave_sum(o * o);
    if ((c & 63) == 0) red[c >> 6] = ss;
    __syncthreads();
    const int h = c >> 7;
    const float ms = (red[2 * h] + red[2 * h + 1]) * (1.f / VD);
    const float yv = o * rsqrtf(ms + EPS);
    Y[(size_t)t * D_MIX + D_CONV + c] = tobf(yv * bf2f(P[(size_t)t * PPITCH + PC_G + D_CONV + c]));
}
__global__ void __launch_bounds__(256) k_sgu_ln(const bf16* __restrict__ P, const float* __restrict__ lg, const float* __restrict__ lb, float* __restrict__ VVLN) {
    __shared__ float red[8];
    const int t = blockIdx.x, c = threadIdx.x;
    const float v = bf2f(P[(size_t)t * PPITCH + PC_VV + c]);
    float s = wave_sum(v);
    if ((c & 63) == 0) red[c >> 6] = s;
    __syncthreads();
    const float mean = (red[0] + red[1] + red[2] + red[3]) * (1.f / D_SGU);
    const float d = v - mean;
    float q = wave_sum(d * d);
    if ((c & 63) == 0) red[4 + (c >> 6)] = q;
    __syncthreads();
    const float var = (red[4] + red[5] + red[6] + red[7]) * (1.f / D_SGU);
    VVLN[(size_t)t * D_SGU + c] = d * rsqrtf(var + EPS) * lg[c] + lb[c];
}
__global__ void __launch_bounds__(256) k_sgu_mix(const bf16* __restrict__ P, const float* __restrict__ VVLN, const float* __restrict__ ws_, const float* __restrict__ bs, bf16* __restrict__ Y) {
    const int t = blockIdx.x, c = threadIdx.x, g = c >> 6;
    const int tl = t & (CHUNK - 1), t0 = t - tl;
    float acc = bs[g * CHUNK + tl];
    for (int s = 0; s <= tl; ++s) acc = fmaf(ws_[((size_t)g * CHUNK + tl) * CHUNK + s], VVLN[(size_t)(t0 + s) * D_SGU + c], acc);
    const float u = bf2f(P[(size_t)t * PPITCH + PC_U + c]);
    Y[(size_t)t * D_MIX + D_CONV + D_ATTN + c] = tobf(u * acc * bf2f(P[(size_t)t * PPITCH + PC_G + D_CONV + D_ATTN + c]));
}
__global__ void __launch_bounds__(256) k_final(float* x, const float* __restrict__ g) {
    const int m = (blockIdx.x * 256 + threadIdx.x) >> 6, lane = threadIdx.x & 63;
    float v[16]; float s = 0.f;
#pragma unroll
    for (int j = 0; j < 16; ++j) { v[j] = x[(size_t)m * D_MODEL + lane + 64 * j]; s += v[j] * v[j]; }
    s = wave_sum(s);
    const float r = rsqrtf(s * (1.f / D_MODEL) + EPS);
#pragma unroll
    for (int j = 0; j < 16; ++j) x[(size_t)m * D_MODEL + lane + 64 * j] = v[j] * r * g[lane + 64 * j];
}
}

#ifndef FAST_MASK
#define FAST_MASK 0xFF
#endif
static void run_naive_phase(int p, const Args& a, hipStream_t stream, int parts = 7) {
    unsigned char* ws = a.ws;
    bf16* XB = (bf16*)(ws + WS_XB); bf16* P = (bf16*)(ws + WS_PROJ); bf16* Y = (bf16*)(ws + WS_Y); float* SSQP = (float*)(ws + WS_SSQP);
    float* Dd = (float*)(ws + WS_DBG_D); float* VVLN = (float*)(ws + WS_DBG_VV);
    if (p == 0) { naive::k_prologue<<<2048, 256, 0, stream>>>(a); naive::k_rowstats<<<M_TOK / 4, 256, 0, stream>>>(a.in[I_X], XB, SSQP); return; }
    if (p == 7) { if (!((FAST_MASK >> 6) & 1)) naive::k_final<<<M_TOK / 4, 256, 0, stream>>>(a.out, a.in[I_NORMF]); return; }
    const int l = (p - 1) / 3, k = (p - 1) % 3;
    const float lam_init = 0.8f - 0.6f * expf(-0.3f * (float)l);
    if (k == 0) {
        naive::k_gemm<0><<<dim3(D_IN / 64, M_TOK / 64), 256, 0, stream>>>(XB, (const bf16*)(ws + WS_WIN) + (size_t)l * D_IN * D_MODEL, M_TOK, D_IN, D_MODEL, P, SSQP, nullptr, nullptr, (bf16*)(ws + WS_KT), (bf16*)(ws + WS_VT), Y);
        naive::k_glu<<<M_TOK, 256, 0, stream>>>(P, Y);
    } else if (k == 1) {
        if (parts & 1) naive::k_conv<<<M_TOK, 256, 0, stream>>>(P, a.in[I_CONVW] + l * CONV_W * D_CONV, a.in[I_CONVB] + l * D_CONV, a.in[I_CLNG] + l * D_CONV, a.in[I_CLNB] + l * D_CONV, Y);
        if (parts & 2) { naive::k_attn<<<dim3(SEQ / 64, BATCH * NH * 8), 64, 0, stream>>>(P, (const bf16*)(ws + WS_KT), (const bf16*)(ws + WS_VT), a.in[I_LQ1] + l * QKD, a.in[I_LK1] + l * QKD, a.in[I_LQ2] + l * QKD, a.in[I_LK2] + l * QKD, lam_init, Dd);
            naive::k_attn_combine<<<M_TOK, 512, 0, stream>>>(Dd, P, a.in[I_SUBG] + l * VD, lam_init, Y); }
        if (parts & 4) { naive::k_sgu_ln<<<M_TOK, 256, 0, stream>>>(P, a.in[I_SLNG] + l * D_SGU, a.in[I_SLNB] + l * D_SGU, VVLN);
            naive::k_sgu_mix<<<M_TOK, 256, 0, stream>>>(P, VVLN, a.in[I_WS] + (size_t)l * NG * CHUNK * CHUNK, a.in[I_BS] + l * NG * CHUNK, Y); }
    } else {
        naive::k_gemm<1><<<dim3(D_MODEL / 64, M_TOK / 64), 256, 0, stream>>>(Y, (const bf16*)(ws + WS_WOUT) + (size_t)l * D_MODEL * D_MIX, M_TOK, D_MODEL, D_MIX, nullptr, nullptr, l == 0 ? a.in[I_X] : nullptr, a.out, nullptr, nullptr, l == 0 ? nullptr : XB);
        naive::k_rowstats<<<M_TOK / 4, 256, 0, stream>>>(a.out, XB, SSQP);
    }
}
extern "C" void kernel_launch(void* const* d_in, const int* in_sizes, int n_in, void* d_out, int out_size, void* d_ws, size_t ws_size, hipStream_t stream) {
    static int grid = 0;
    if (grid == 0) {
        if (n_in != 18 || out_size != M_TOK * D_MODEL) { fprintf(stderr, "kernel_launch: unexpected shapes (n_in %d, out %d); nothing launched\n", n_in, out_size); grid = -1; return; }
        int dev = 0, cus = 0, per_cu = 0;
        if (hipGetDevice(&dev) != hipSuccess || hipDeviceGetAttribute(&cus, hipDeviceAttributeMultiprocessorCount, dev) != hipSuccess) { grid = -1; return; }
        if (hipFuncSetAttribute((const void*)mk_fwd, hipFuncAttributeMaxDynamicSharedMemorySize, LDS_BYTES) != hipSuccess) { fprintf(stderr, "kernel_launch: hipFuncSetAttribute failed\n"); grid = -1; return; }
        if (hipOccupancyMaxActiveBlocksPerMultiprocessor(&per_cu, (const void*)mk_fwd, NWAVES * 64, LDS_BYTES) != hipSuccess || per_cu < 1) { fprintf(stderr, "kernel_launch: occupancy query reports %d blocks per CU\n", per_cu); }
        (void)hipGetLastError();
        grid = cus;
        if (grid != 256) fprintf(stderr, "kernel_launch: %d CUs; this kernel is built for 256\n", grid);
    }
    if (grid < 0) return;
    Args a{};
    for (int i = 0; i < 18; ++i) a.in[i] = (const float*)d_in[i];
    a.out = (float*)d_out; a.ws = (unsigned char*)d_ws; a.dry = 1;
    int p = 0;
    while (p < N_PHASES) {
        if ((FAST_MASK >> p) & 1) {
            int q = p;
#ifdef SINGLE_PHASE_LAUNCH
            q = p + 1;
#else
            while (q < N_PHASES && ((FAST_MASK >> q) & 1)) ++q;
#endif
            (void)hipMemsetAsync((char*)d_ws + WS_CTL, 0, CTL_ZERO_BYTES, stream);
            a.ph_lo = p; a.ph_hi = q;
            hipLaunchKernelGGL(mk_fwd, dim3(grid), dim3(NWAVES * 64), LDS_BYTES, stream, a);
#ifdef SINGLE_PHASE_LAUNCH
            if (p == 2 || p == 5) { const int parts = (MIX_CONV ? 0 : 1) | (MIX_ATTN ? 0 : 2) | (MIX_SGU ? 0 : 4); if (parts) run_naive_phase(p, a, stream, parts); }
#endif
            p = q;
        } else { run_naive_phase(p, a, stream); ++p; }
    }
}
```
